# Optimizing an MI355X kernel written in HIP

```python
import jax, jax.numpy as jnp
from jax import lax
import numpy as np

D_MODEL = 1024
BATCH = 16
SEQ = 256
DEPTH = 1
DEC_BATCH = 2
DEC_SEQ = 2048
PAST_LEN = 256

GRID_W = 64
NH = 4
DK = 128
DV = 256
D_A = NH * DV
CHUNK = 64
POOL_WINDOWS = (2, 4, 8, 16)
POOL_GROUP = 128
D_POOL = POOL_GROUP * len(POOL_WINDOWS)
D_FF = 2816
CONV_W = 3
EPS = 1e-6
IN_SIZES = (NH * DK, NH * DK, D_A, D_A, 2 * NH, 2 * NH, D_POOL, D_MODEL, D_MODEL)
IN_COLS = int(sum(IN_SIZES))
IN_SPLIT_POINTS = [int(s) for s in np.cumsum(IN_SIZES)[:-1]]

kernel_name = 'bidir_mlstm_pool_hybrid_diffusion_step'


def _rmsnorm(x, g):
    xf = x.astype(jnp.float32)
    y = xf * lax.rsqrt(jnp.mean(xf * xf, axis=-1, keepdims=True) + EPS)
    return (y * g.astype(jnp.float32)).astype(x.dtype)


def _mlstm_chunked(q, k, v, log_i, log_f, C0, n0, m0):
    B, H, S, _ = q.shape
    nc = S // CHUNK
    qc = q.reshape(B, H, nc, CHUNK, DK)
    kc = k.reshape(B, H, nc, CHUNK, DK)
    vc = v.reshape(B, H, nc, CHUNK, DV)
    li = log_i.reshape(B, H, nc, CHUNK)
    b = jnp.cumsum(log_f.reshape(B, H, nc, CHUNK), axis=-1)
    b_last = b[..., -1]
    w = b_last[..., None] - b + li
    w_max = jnp.max(w, axis=-1)
    ew = jnp.exp(w - w_max[..., None])
    kv_chunk = jnp.einsum('bhcsk,bhcsv->bhckv', kc * ew[..., None], vc)
    n_chunk = jnp.einsum('bhcs,bhcsk->bhck', ew, kc)

    def step(carry, xs):
        C, n, m = carry
        kv_c, n_c, wmax_c, blast_c = xs
        m_new = jnp.maximum(m + blast_c, wmax_c)
        a = jnp.exp(m + blast_c - m_new)
        g = jnp.exp(wmax_c - m_new)
        C_new = a[..., None, None] * C + g[..., None, None] * kv_c
        n_new = a[..., None] * n + g[..., None] * n_c
        return (C_new, n_new, m_new), (C, n, m)

    xs = (jnp.moveaxis(kv_chunk, 2, 0), jnp.moveaxis(n_chunk, 2, 0),
          jnp.moveaxis(w_max, 2, 0), jnp.moveaxis(b_last, 2, 0))
    (Cf, nf, mf), (Cs, ns, ms) = lax.scan(step, (C0, n0, m0), xs)
    Cs = jnp.moveaxis(Cs, 0, 2)
    ns = jnp.moveaxis(ns, 0, 2)
    ms = jnp.moveaxis(ms, 0, 2)
    D = b[..., :, None] - b[..., None, :] + li[..., None, :]
    causal = np.tril(np.ones((CHUNK, CHUNK), dtype=bool))
    D = jnp.where(causal, D, -jnp.inf)
    inter = ms[..., None] + b
    m_t = jnp.maximum(inter, jnp.max(D, axis=-1))
    wts = jnp.exp(D - m_t[..., None])
    sc = jnp.exp(inter - m_t)
    qk = jnp.einsum('bhctk,bhcsk->bhcts', qc, kc) * wts
    num = jnp.einsum('bhcts,bhcsv->bhctv', qk, vc) + sc[..., None] * jnp.einsum('bhctk,bhckv->bhctv', qc, Cs)
    den = jnp.sum(qk, axis=-1) + sc * jnp.einsum('bhctk,bhck->bhct', qc, ns)
    h = num / jnp.maximum(jnp.abs(den), jnp.exp(-m_t))[..., None]
    return h.reshape(B, H, S, DV), (Cf, nf, mf)


def _pool_mixer(u, grid, w_pool, pool_scale):
    B, L, C = u.shape
    rows, cols = grid
    ur = u.astype(jnp.float32).reshape(B, rows, cols, C)
    cs = jnp.concatenate([jnp.zeros((B, rows, 1, C), jnp.float32), jnp.cumsum(ur, axis=2)], axis=2)
    t = np.arange(cols)
    outs = []
    for gi, win in enumerate(POOL_WINDOWS):
        lo = np.clip(t - win // 2, 0, cols)
        hi = np.clip(t + win // 2, 0, cols)
        cnt = (hi - lo).astype(np.float32)[:, None]
        sl = slice(gi * POOL_GROUP, (gi + 1) * POOL_GROUP)
        csg = cs[..., sl]
        mean = (jnp.take(csg, hi, axis=2) - jnp.take(csg, lo, axis=2)) / cnt
        d = mean - ur[..., sl]
        outs.append(jnp.einsum('brtc,cd->brtd', d, w_pool[gi].astype(jnp.float32)))
    y = jnp.concatenate(outs, axis=-1) * pool_scale.astype(jnp.float32)
    return y.reshape(B, L, C).astype(u.dtype)


def _dwconv_rows(h, w, bias, grid):
    B, L, C = h.shape
    rows, cols = grid
    hr = h.reshape(B, rows, cols, C)
    hp = jnp.pad(hr, ((0, 0), (0, 0), (1, 1), (0, 0)))
    out = hp[:, :, 0:cols] * w[0] + hp[:, :, 1:cols + 1] * w[1] + hp[:, :, 2:cols + 2] * w[2] + bias
    return out.reshape(B, L, C)


def _layer(x, cond, C0, n0, m0, grid, p):
    (w_ada, b_ada, g_pre_mix, g_post_mix, g_pre_ffn, g_post_ffn, w_in, b_gates, g_head,
     w_pool, pool_scale, w_br_a, w_br_b, w_out, w_up, conv_w, conv_b, w_down) = p
    B, L, _ = x.shape
    dt = x.dtype
    f32 = jnp.float32
    mod = jnp.dot(jax.nn.silu(cond), w_ada) + b_ada
    sh1, sc1, gt1, sh2, sc2, gt2 = [m[:, None, :] for m in jnp.split(mod, 6, axis=-1)]
    h = _rmsnorm(x, g_pre_mix) * (1 + sc1) + sh1
    z = jnp.einsum('bld,de->ble', h, w_in)
    q, k, v, o, ig, fg, u, ga, gb = jnp.split(z, IN_SPLIT_POINTS, axis=-1)
    qh = q.reshape(B, L, NH, DK).transpose(0, 2, 1, 3).astype(f32) * (DK ** -0.5)
    kh = k.reshape(B, L, NH, DK).transpose(0, 2, 1, 3).astype(f32)
    vh = v.reshape(B, L, NH, DV).transpose(0, 2, 1, 3).astype(f32)
    b_i, b_f = jnp.split(b_gates.astype(f32), 2)
    log_i = (ig.astype(f32) + b_i).reshape(B, L, 2, NH).transpose(2, 0, 3, 1)
    log_f = jax.nn.log_sigmoid(fg.astype(f32) + b_f).reshape(B, L, 2, NH).transpose(2, 0, 3, 1)
    h_f, (Cf, nf, mf) = _mlstm_chunked(qh, kh, vh, log_i[0], log_f[0], C0[:, 0], n0[:, 0], m0[:, 0])
    rev = lambda a: jnp.flip(a, axis=2)
    h_b, (Cb, nb, mb) = _mlstm_chunked(rev(qh), rev(kh), rev(vh), rev(log_i[1]), rev(log_f[1]),
                                       C0[:, 1], n0[:, 1], m0[:, 1])
    hm = h_f + rev(h_b)
    hm = hm * lax.rsqrt(jnp.mean(hm * hm, axis=-1, keepdims=True) + EPS) * g_head.astype(f32)[None, :, None, :]
    hm = hm.transpose(0, 2, 1, 3).reshape(B, L, D_A).astype(dt) * jax.nn.sigmoid(o)
    ya = jnp.einsum('blc,cd->bld', hm, w_br_a)
    yb = jnp.einsum('blc,cd->bld', _pool_mixer(u, grid, w_pool, pool_scale), w_br_b)
    y = jnp.einsum('bld,de->ble', jax.nn.sigmoid(ga) * ya + jax.nn.sigmoid(gb) * yb, w_out)
    x = x + gt1 * _rmsnorm(y, g_post_mix)
    h2 = _rmsnorm(x, g_pre_ffn) * (1 + sc2) + sh2
    up = _dwconv_rows(jnp.einsum('bld,df->blf', h2, w_up), conv_w, conv_b, grid)
    ug, uv = jnp.split(up, 2, axis=-1)
    f = jnp.einsum('blf,fd->bld', jax.nn.gelu(ug) * uv, w_down)
    x = x + gt2 * _rmsnorm(f, g_post_ffn)
    return x, (jnp.stack([Cf, Cb], axis=1), jnp.stack([nf, nb], axis=1), jnp.stack([mf, mb], axis=1))


def setup_inputs(seed: int = 0) -> dict:
    key = jax.random.key(seed)
    ks = jax.random.split(key, 32)
    nrm = lambda kk, shape, s: jax.random.normal(kk, shape, jnp.float32) * s
    gain = lambda kk, shape: 1.0 + 0.05 * jax.random.normal(kk, shape, jnp.float32)
    b_i = -1.0 + 0.1 * jax.random.normal(ks[10], (DEPTH, 2 * NH), jnp.float32)
    b_f = jnp.linspace(3.0, 6.0, 2 * NH, dtype=jnp.float32)[None, :] + 0.1 * jax.random.normal(ks[11], (DEPTH, 2 * NH), jnp.float32)
    return {
        'x_prompt': nrm(ks[0], (BATCH, SEQ, D_MODEL), 1.0),
        'x_sample': nrm(ks[1], (DEC_BATCH, DEC_SEQ, D_MODEL), 1.0),
        'state_C': nrm(ks[2], (DEC_BATCH, DEPTH, 2, NH, DK, DV), DK ** -0.5),
        'state_n': nrm(ks[3], (DEC_BATCH, DEPTH, 2, NH, DK), DK ** -0.5),
        'state_m': nrm(ks[4], (DEC_BATCH, DEPTH, 2, NH), 0.5),
        'c': nrm(ks[5], (DEC_BATCH, D_MODEL), 1.0),
        'c_ctx': nrm(ks[6], (D_MODEL,), 1.0),
        'w_ada': nrm(ks[7], (DEPTH, D_MODEL, 6 * D_MODEL), 0.5 * D_MODEL ** -0.5),
        'b_ada': nrm(ks[8], (DEPTH, 6 * D_MODEL), 0.02),
        'g_pre_mix': gain(ks[9], (DEPTH, D_MODEL)),
        'g_post_mix': gain(ks[12], (DEPTH, D_MODEL)),
        'g_pre_ffn': gain(ks[13], (DEPTH, D_MODEL)),
        'g_post_ffn': gain(ks[14], (DEPTH, D_MODEL)),
        'w_in': nrm(ks[15], (DEPTH, D_MODEL, IN_COLS), D_MODEL ** -0.5),
        'b_gates': jnp.concatenate([b_i, b_f], axis=-1),
        'g_head': gain(ks[16], (DEPTH, NH, DV)),
        'w_pool': nrm(ks[17], (DEPTH, len(POOL_WINDOWS), POOL_GROUP, POOL_GROUP), POOL_GROUP ** -0.5),
        'pool_scale': 1.0 + 0.1 * jax.random.normal(ks[18], (DEPTH, D_POOL), jnp.float32),
        'w_br_a': nrm(ks[19], (DEPTH, D_A, D_MODEL), D_A ** -0.5),
        'w_br_b': nrm(ks[20], (DEPTH, D_POOL, D_MODEL), D_POOL ** -0.5),
        'w_out': nrm(ks[21], (DEPTH, D_MODEL, D_MODEL), D_MODEL ** -0.5),
        'w_up': nrm(ks[22], (DEPTH, D_MODEL, 2 * D_FF), D_MODEL ** -0.5),
        'conv_w': nrm(ks[23], (DEPTH, CONV_W, 2 * D_FF), CONV_W ** -0.5),
        'conv_b': nrm(ks[24], (DEPTH, 2 * D_FF), 0.02),
        'w_down': nrm(ks[25], (DEPTH, D_FF, D_MODEL), D_FF ** -0.5),
    }


def reference(x_prompt, x_sample, state_C, state_n, state_m, c, c_ctx, w_ada, b_ada,
              g_pre_mix, g_post_mix, g_pre_ffn, g_post_ffn, w_in, b_gates, g_head,
              w_pool, pool_scale, w_br_a, w_br_b, w_out, w_up, conv_w, conv_b, w_down):
    Bp, Lp, _ = x_prompt.shape
    Bs, Ls, _ = x_sample.shape
    rows = Ls // GRID_W
    f32 = jnp.float32
    cond_ctx = jnp.broadcast_to(c_ctx[None, :], (Bp, D_MODEL))
    zC = jnp.zeros((Bp, 2, NH, DK, DV), f32)
    zn = jnp.zeros((Bp, 2, NH, DK), f32)
    zm = jnp.zeros((Bp, 2, NH), f32)
    y_p = x_prompt
    y_s = x_sample
    new_C, new_n, new_m = [], [], []
    for l in range(DEPTH):
        p = (w_ada[l], b_ada[l], g_pre_mix[l], g_post_mix[l], g_pre_ffn[l], g_post_ffn[l], w_in[l],
             b_gates[l], g_head[l], w_pool[l], pool_scale[l], w_br_a[l], w_br_b[l], w_out[l],
             w_up[l], conv_w[l], conv_b[l], w_down[l])
        y_p, (Cl, nl, ml) = _layer(y_p, cond_ctx, zC, zn, zm, (1, Lp), p)
        new_C.append(Cl)
        new_n.append(nl)
        new_m.append(ml)
        y_s, _ = _layer(y_s, c, state_C[:, l].astype(f32), state_n[:, l].astype(f32),
                        state_m[:, l].astype(f32), (rows, GRID_W), p)
    new_state_C = jnp.stack(new_C, axis=1).astype(state_C.dtype)
    new_state_n = jnp.stack(new_n, axis=1).astype(state_n.dtype)
    new_state_m = jnp.stack(new_m, axis=1).astype(state_m.dtype)
    return (y_p, y_s, new_state_C, new_state_n, new_state_m)
```

```cpp
#include <hip/hip_runtime.h>
#include <hip/hip_cooperative_groups.h>
#include <cstdio>
namespace cg = cooperative_groups;

#define LAS __attribute__((address_space(3)))
typedef unsigned short bf16_t;
typedef short bf16x8 __attribute__((ext_vector_type(8)));
typedef float f32x4 __attribute__((ext_vector_type(4)));
typedef float f32x2 __attribute__((ext_vector_type(2)));
typedef unsigned u32x4 __attribute__((ext_vector_type(4)));
typedef unsigned u32x2 __attribute__((ext_vector_type(2)));

constexpr int DM = 1024, NTOK = 8192, NPROMPT = 4096;
constexpr int INC = 5648, NZ = 5632, DFF = 2816, NUP = 5632;
constexpr float EPSN = 1e-6f;
constexpr size_t MiB = 1u << 20;
constexpr size_t OFF_WT_IN = 0, OFF_WT_UP = 11 * MiB, OFF_WT_DOWN = 22 * MiB, OFF_WT_BRA = 28 * MiB, OFF_WT_EFF = 30 * MiB, OFF_WT_OUT = 31 * MiB;
constexpr size_t OFF_SMALL = 33 * MiB;
constexpr size_t OFF_MODCNT = OFF_SMALL + 1280 * 1024 + 16128, OFF_MOD = OFF_SMALL + 1280 * 1024 + 16384, OFF_GATES = OFF_SMALL + 128 * 1024, OFF_NCH = OFF_SMALL + 640 * 1024, OFF_WMAX = OFF_SMALL + 1152 * 1024,
                 OFF_BLAST = OFF_SMALL + 1156 * 1024, OFF_MS = OFF_SMALL + 1160 * 1024;
constexpr size_t OFF_H1 = 35 * MiB, OFF_KV = 51 * MiB, OFF_T = 51 * MiB, OFF_X1 = 83 * MiB, OFF_SGA = 115 * MiB, OFF_SGB = 131 * MiB, OFF_DP = 147 * MiB,
                 OFF_HM = 155 * MiB, OFF_Q = 171 * MiB, OFF_KN = 179 * MiB, OFF_KT = 187 * MiB, OFF_VT = 195 * MiB, OFF_SO = 211 * MiB, OFF_U = 227 * MiB,
                 OFF_UP = 115 * MiB, OFF_ACT = 203 * MiB, WS_NEED = 247 * MiB;
constexpr int OUT_C = 8388608, OUT_N = 12582912, OUT_M = 12599296;

struct Params { const float* in[25]; float* out; unsigned char* ws; };

typedef __bf16 bf16v2 __attribute__((ext_vector_type(2)));
__device__ __forceinline__ unsigned cvt_pk_bf16(float lo, float hi) { f32x2 v = {lo, hi}; bf16v2 b = __builtin_convertvector(v, bf16v2); return __builtin_bit_cast(unsigned, b); }
__device__ __forceinline__ float bf_lo(unsigned u) { return __uint_as_float(u << 16); }
__device__ __forceinline__ float bf_hi(unsigned u) { return __uint_as_float(u & 0xffff0000u); }
__device__ __forceinline__ float bf2f(bf16_t b) { return __uint_as_float(((unsigned)b) << 16); }
__device__ __forceinline__ float sigmoidf_(float x) { return __builtin_amdgcn_rcpf(1.0f + __expf(-x)); }
__device__ __forceinline__ float wave_sum(float v) {
#pragma unroll
    for (int o = 1; o < 64; o <<= 1) v += __shfl_xor(v, o);
    return v;
}

namespace pg8 {
constexpr int BM = 256, BK = 64, HALF = 128, HTB = HALF * BK * 2, STAGE_BYTES = 8 * HTB, NXCD = 8, WGM = 8;
__host__ __device__ __forceinline__ int lds_byte(int r, int c) { const int st = (r >> 4) * 2 + (c >> 5), rr = r & 15, cc = c & 31, ob = rr * 64 + cc * 2; return st * 1024 + (ob ^ (((ob >> 9) & 1) << 5)); }
__host__ __device__ __forceinline__ void stage_rc(int b, int& R, int& C) { const int st = b / 1024, sb = b % 1024, swz = sb ^ (((sb >> 9) & 1) << 5); R = (st >> 1) * 16 + swz / 64; C = (st & 1) * 32 + (swz % 64) / 2; }
__host__ __device__ __forceinline__ int perm32(int rho) { const int n = rho >> 4, i = rho & 15; return 8 * (i >> 2) + 4 * n + (i & 3); }
struct Unit { int pm, pn; };
struct Gemm { const bf16_t* A; const bf16_t* Bt; int M, N, K; int ld; int nNr; };
struct StaticOrder {
    int nM, nN, nwg, G, c, rep;
    __device__ void init(int M, int N, int G_, int c_, int rep_ = 1) { nM = M / BM; nN = N / BM; nwg = nM * nN; G = G_; c = c_; rep = rep_; }
    __device__ bool next(int i, Unit& u) const {
        const long L = (long)(i / rep) * G + c; if (L >= nwg) return false;
        int wgid = (int)L; { const int q = nwg / NXCD, r = nwg % NXCD, xcd = wgid % NXCD, off = wgid / NXCD; wgid = (xcd < r ? xcd * (q + 1) : r * (q + 1) + (xcd - r) * q) + off; }
        const int nig = WGM * nN, gid = wgid / nig, fm = gid * WGM, gsz = (nM - fm) < WGM ? (nM - fm) : WGM;
        u.pm = fm + ((wgid % nig) % gsz); u.pn = (wgid % nig) / gsz; return true;
    }
};

template <class Epi>
__device__ __forceinline__ void gemm_phase(LAS unsigned char* lds, const Gemm g, const StaticOrder& S, const Epi& E) {
    int tid = threadIdx.x; asm volatile("" : "+v"(tid));
    const int wid = __builtin_amdgcn_readfirstlane(tid >> 6), lane = tid & 63, wr = wid >> 2, wc = wid & 3, fr = lane & 15, fq = lane >> 4;
    const int K = g.K, nt = K / BK;
    unsigned voffA[2], voffB[2];
#pragma unroll
    for (int i = 0; i < 2; ++i) { int R, C; stage_rc(tid * 16 + i * 8192, R, C); const int Rb = Epi::PERM ? ((R & ~31) + perm32(R & 31)) : R;
        voffA[i] = (unsigned)(R * g.ld + C) * 2u; voffB[i] = (unsigned)(Rb * g.ld + C) * 2u; }
    const size_t kstep = (size_t)(BK * 2);
    const size_t hstep = (size_t)HALF * g.ld * 2;
    const size_t tstep = 2 * hstep;
    const unsigned ldsw = (unsigned)wid * 1024u;
    const int aoff = lds_byte(wr * 64 + fr, fq * 8), boff = lds_byte(wc * 32 + fr, fq * 8);
#define PG8_SA(b, h) (((b) * 2 + (h)) * HTB)
#define PG8_SB(b, h) ((4 + (b) * 2 + (h)) * HTB)
#define PG8_STAGE(bufoff, gbase, voff) do { _Pragma("unroll") for (int _i = 0; _i < 2; ++_i) \
        __builtin_amdgcn_global_load_lds((const unsigned*)((const char*)(gbase) + (voff)[_i]), (LAS unsigned*)(lds + (bufoff) + ldsw + _i * 8192), 16, 0, 0); } while (0)
#define PG8_LDA(dst, b, h) do { _Pragma("unroll") for (int m = 0; m < 4; ++m) _Pragma("unroll") for (int k = 0; k < 2; ++k) dst[m][k] = *(const LAS bf16x8*)(lds + PG8_SA(b, h) + aoff + m * 2048 + k * 1024); } while (0)
#define PG8_LDB(dst, b, h) do { _Pragma("unroll") for (int n = 0; n < 2; ++n) _Pragma("unroll") for (int k = 0; k < 2; ++k) dst[n][k] = *(const LAS bf16x8*)(lds + PG8_SB(b, h) + boff + n * 2048 + k * 1024); } while (0)
#define PG8_MMA(ai, bj, At, Bt) do { __builtin_amdgcn_s_setprio(1); _Pragma("unroll") for (int m = 0; m < 4; ++m) _Pragma("unroll") for (int n = 0; n < 2; ++n) _Pragma("unroll") for (int k = 0; k < 2; ++k) \
        acc[ai][bj][m][n] = __builtin_amdgcn_mfma_f32_16x16x32_bf16(Bt[n][k], At[m][k], acc[ai][bj][m][n], 0, 0, 0); __builtin_amdgcn_s_setprio(0); } while (0)
#define PG8_WAIT_V(n) asm volatile("s_waitcnt vmcnt(" #n ")" ::: "memory")
#define PG8_WAIT_L(n) asm volatile("s_waitcnt lgkmcnt(" #n ")" ::: "memory")
#define PG8_BAR __builtin_amdgcn_s_barrier()
#define PG8_SCHED __builtin_amdgcn_sched_barrier(0)
    Unit cur, nxt; int ui = 0;
    if (!S.next(0, cur)) return;
    f32x4 acc[2][2][4][2];
#pragma unroll
    for (int a = 0; a < 2; ++a)
#pragma unroll
        for (int b = 0; b < 2; ++b)
#pragma unroll
            for (int m = 0; m < 4; ++m)
#pragma unroll
                for (int n = 0; n < 2; ++n) acc[a][b][m][n] = (f32x4){0.f, 0.f, 0.f, 0.f};
    bf16x8 At[4][2], B0[2][2], B1[2][2];
    const char* cA = (const char*)g.A + (size_t)cur.pm * tstep + (size_t)(cur.pn / g.nNr) * K * 2; const char* cB = (const char*)g.Bt + (size_t)(cur.pn % g.nNr) * tstep + (size_t)(cur.pn / g.nNr) * K * 2;
    PG8_STAGE(PG8_SB(0, 0), cB, voffB); PG8_STAGE(PG8_SA(0, 0), cA, voffA); PG8_STAGE(PG8_SB(0, 1), cB + hstep, voffB); PG8_STAGE(PG8_SA(0, 1), cA + hstep, voffA);
    if (wr == 1) PG8_BAR;
    PG8_WAIT_V(4); PG8_BAR;
    PG8_STAGE(PG8_SB(1, 0), cB + kstep, voffB); PG8_STAGE(PG8_SA(1, 0), cA + kstep, voffA); PG8_STAGE(PG8_SB(1, 1), cB + hstep + kstep, voffB);
    PG8_WAIT_V(6); PG8_BAR;
    for (;;) {
        const bool has_next = S.next(ui + 1, nxt);
        const char* nA = has_next ? (const char*)g.A + (size_t)nxt.pm * tstep + (size_t)(nxt.pn / g.nNr) * K * 2 : cA; const char* nB = has_next ? (const char*)g.Bt + (size_t)(nxt.pn % g.nNr) * tstep + (size_t)(nxt.pn / g.nNr) * K * 2 : cB;
        for (int t = 0; t < nt; t += 2) {
            const bool last = (t == nt - 2);
            const char* a1 = cA + (size_t)(t + 1) * kstep;
            const char* a2 = last ? nA : cA + (size_t)(t + 2) * kstep; const char* b2 = last ? nB : cB + (size_t)(t + 2) * kstep;
            const char* a3 = a2 + kstep; const char* b3 = b2 + kstep;
            PG8_LDB(B0, 0, 0); PG8_SCHED; PG8_LDA(At, 0, 0); PG8_STAGE(PG8_SA(1, 1), a1 + hstep, voffA);
            PG8_WAIT_L(8); PG8_BAR; PG8_WAIT_L(0); PG8_MMA(0, 0, At, B0); PG8_BAR; PG8_SCHED;
            PG8_LDB(B1, 0, 1); PG8_STAGE(PG8_SB(0, 0), b2, voffB);
            PG8_BAR; PG8_WAIT_L(0); PG8_MMA(0, 1, At, B1); PG8_BAR;
            PG8_LDA(At, 0, 1); PG8_STAGE(PG8_SA(0, 0), a2, voffA);
            PG8_BAR; PG8_WAIT_L(0); PG8_MMA(1, 0, At, B0); PG8_BAR; PG8_SCHED;
            PG8_STAGE(PG8_SB(0, 1), b2 + hstep, voffB);
            PG8_WAIT_V(6); PG8_BAR; PG8_MMA(1, 1, At, B1); PG8_BAR;
            PG8_LDB(B0, 1, 0); PG8_SCHED; PG8_LDA(At, 1, 0); PG8_STAGE(PG8_SA(0, 1), a2 + hstep, voffA);
            PG8_WAIT_L(8); PG8_BAR; PG8_WAIT_L(0); PG8_MMA(0, 0, At, B0); PG8_BAR; PG8_SCHED;
            PG8_LDB(B1, 1, 1); PG8_STAGE(PG8_SB(1, 0), b3, voffB);
            PG8_BAR; PG8_WAIT_L(0); PG8_MMA(0, 1, At, B1); PG8_BAR;
            PG8_LDA(At, 1, 1); PG8_STAGE(PG8_SA(1, 0), a3, voffA);
            PG8_BAR; PG8_WAIT_L(0); PG8_MMA(1, 0, At, B0); PG8_BAR; PG8_SCHED;
            PG8_STAGE(PG8_SB(1, 1), b3 + hstep, voffB);
            PG8_WAIT_V(6); PG8_BAR; PG8_MMA(1, 1, At, B1); PG8_BAR;
        }
        E(acc, cur, wr, wc, fr, fq);
        if (!has_next) break;
#pragma unroll
        for (int a = 0; a < 2; ++a)
#pragma unroll
            for (int b = 0; b < 2; ++b)
#pragma unroll
                for (int m = 0; m < 4; ++m)
#pragma unroll
                    for (int n = 0; n < 2; ++n) acc[a][b][m][n] = (f32x4){0.f, 0.f, 0.f, 0.f};
        cur = nxt; cA = nA; cB = nB; ++ui;
    }
    PG8_WAIT_V(0);
    if (wr == 0) PG8_BAR;
    PG8_BAR;
#undef PG8_SA
#undef PG8_SB
#undef PG8_STAGE
#undef PG8_LDA
#undef PG8_LDB
#undef PG8_MMA
#undef PG8_WAIT_V
#undef PG8_WAIT_L
#undef PG8_BAR
#undef PG8_SCHED
}
}
using pg8::Unit;
#define EPI_LOOP_BEGIN \
    const int row0 = u.pm * 256 + wr * 64 + fr, colt = u.pn * 256 + wc * 32 + 8 * fq; \
    _Pragma("unroll") for (int ai = 0; ai < 2; ++ai) _Pragma("unroll") for (int m = 0; m < 4; ++m) { const int row = row0 + ai * 128 + m * 16; \
    _Pragma("unroll") for (int bj = 0; bj < 2; ++bj) { const int col = colt + bj * 128; f32x4 v0 = acc[ai][bj][m][0], v1 = acc[ai][bj][m][1];
#define EPI_LOOP_END } }

__device__ __forceinline__ u32x4 pack8(f32x4 v0, f32x4 v1) { u32x4 w; w.x = cvt_pk_bf16(v0[0], v0[1]); w.y = cvt_pk_bf16(v0[2], v0[3]); w.z = cvt_pk_bf16(v1[0], v1[1]); w.w = cvt_pk_bf16(v1[2], v1[3]); return w; }
__device__ __forceinline__ void unpack8(u32x4 w, f32x4& v0, f32x4& v1) { v0 = (f32x4){bf_lo(w.x), bf_hi(w.x), bf_lo(w.y), bf_hi(w.y)}; v1 = (f32x4){bf_lo(w.z), bf_hi(w.z), bf_lo(w.w), bf_hi(w.w)}; }

struct EpiZ {
    static constexpr bool PERM = true;
    bf16_t *Q, *Kn, *KT, *VT, *SO, *U, *SGA, *SGB;
    __device__ __forceinline__ void operator()(const f32x4 (&acc)[2][2][4][2], const Unit& u, int wr, int wc, int fr, int fq) const {
        const int pn = u.pn;
        if (pn < 2) {
            EPI_LOOP_BEGIN
                v0 *= 0.08838834764831845f; v1 *= 0.08838834764831845f;
                *(u32x4*)(Q + (size_t)row * 512 + col) = pack8(v0, v1);
            EPI_LOOP_END
        } else if (pn < 4) {
            EPI_LOOP_BEGIN
                const int c = col - 512;
                u32x4 w = pack8(v0, v1);
                *(u32x4*)(Kn + (size_t)row * 512 + c) = w;
                bf16_t* tp = KT + (size_t)c * NTOK + row;
                tp[0] = (bf16_t)(w.x & 0xffffu); tp[NTOK] = (bf16_t)(w.x >> 16); tp[2 * NTOK] = (bf16_t)(w.y & 0xffffu); tp[3 * NTOK] = (bf16_t)(w.y >> 16);
                tp[4 * NTOK] = (bf16_t)(w.z & 0xffffu); tp[5 * NTOK] = (bf16_t)(w.z >> 16); tp[6 * NTOK] = (bf16_t)(w.w & 0xffffu); tp[7 * NTOK] = (bf16_t)(w.w >> 16);
            EPI_LOOP_END
        } else if (pn < 8) {
            EPI_LOOP_BEGIN
                const int c = col - 1024;
                u32x4 w = pack8(v0, v1);
                bf16_t* tp = VT + (size_t)c * NTOK + row;
                tp[0] = (bf16_t)(w.x & 0xffffu); tp[NTOK] = (bf16_t)(w.x >> 16); tp[2 * NTOK] = (bf16_t)(w.y & 0xffffu); tp[3 * NTOK] = (bf16_t)(w.y >> 16);
                tp[4 * NTOK] = (bf16_t)(w.z & 0xffffu); tp[5 * NTOK] = (bf16_t)(w.z >> 16); tp[6 * NTOK] = (bf16_t)(w.w & 0xffffu); tp[7 * NTOK] = (bf16_t)(w.w >> 16);
            EPI_LOOP_END
        } else if (pn < 12) {
            EPI_LOOP_BEGIN
#pragma unroll
                for (int j = 0; j < 4; ++j) { v0[j] = sigmoidf_(v0[j]); v1[j] = sigmoidf_(v1[j]); }
                *(u32x4*)(SO + (size_t)row * 1024 + (col - 2048)) = pack8(v0, v1);
            EPI_LOOP_END
        } else if (pn < 14) {
            EPI_LOOP_BEGIN
                *(u32x4*)(U + (size_t)row * 512 + (col - 3072)) = pack8(v0, v1);
            EPI_LOOP_END
        } else if (pn < 18) {
            EPI_LOOP_BEGIN
#pragma unroll
                for (int j = 0; j < 4; ++j) { v0[j] = sigmoidf_(v0[j]); v1[j] = sigmoidf_(v1[j]); }
                *(u32x4*)(SGA + (size_t)row * 1024 + (col - 3584)) = pack8(v0, v1);
            EPI_LOOP_END
        } else {
            EPI_LOOP_BEGIN
#pragma unroll
                for (int j = 0; j < 4; ++j) { v0[j] = sigmoidf_(v0[j]); v1[j] = sigmoidf_(v1[j]); }
                *(u32x4*)(SGB + (size_t)row * 1024 + (col - 4608)) = pack8(v0, v1);
            EPI_LOOP_END
        }
    }
};
struct EpiT1 {
    static constexpr bool PERM = true;
    bf16_t* T; const bf16_t* SG;
    __device__ __forceinline__ void operator()(const f32x4 (&acc)[2][2][4][2], const Unit& u, int wr, int wc, int fr, int fq) const {
        const int row0 = u.pm * 256 + wr * 64 + fr, colt = u.pn * 256 + wc * 32 + 8 * fq;
#pragma unroll
        for (int ai = 0; ai < 2; ++ai) {
            u32x4 sg[4][2];
#pragma unroll
            for (int m = 0; m < 4; ++m)
#pragma unroll
                for (int bj = 0; bj < 2; ++bj) sg[m][bj] = __builtin_nontemporal_load((const u32x4*)(SG + (size_t)(row0 + ai * 128 + m * 16) * 1024 + colt + bj * 128));
#pragma unroll
            for (int m = 0; m < 4; ++m)
#pragma unroll
                for (int bj = 0; bj < 2; ++bj) { f32x4 g0, g1; unpack8(sg[m][bj], g0, g1);
                    *(u32x4*)(T + (size_t)(row0 + ai * 128 + m * 16) * 1024 + colt + bj * 128) = pack8(acc[ai][bj][m][0] * g0, acc[ai][bj][m][1] * g1); }
        }
    }
};
struct EpiMix {
    static constexpr bool PERM = true;
    const bf16_t* T; const bf16_t* SG; bf16_t* O;
    __device__ __forceinline__ void operator()(const f32x4 (&acc)[2][2][4][2], const Unit& u, int wr, int wc, int fr, int fq) const {
        const int row0 = u.pm * 256 + wr * 64 + fr, colt = u.pn * 256 + wc * 32 + 8 * fq;
#pragma unroll
        for (int ai = 0; ai < 2; ++ai)
#pragma unroll
            for (int mh = 0; mh < 2; ++mh) {
                u32x4 sg[2][2], tt[2][2];
#pragma unroll
                for (int mm = 0; mm < 2; ++mm)
#pragma unroll
                    for (int bj = 0; bj < 2; ++bj) { const size_t o = (size_t)(row0 + ai * 128 + (2 * mh + mm) * 16) * 1024 + colt + bj * 128;
                        sg[mm][bj] = __builtin_nontemporal_load((const u32x4*)(SG + o)); tt[mm][bj] = __builtin_nontemporal_load((const u32x4*)(T + o)); }
#pragma unroll
                for (int mm = 0; mm < 2; ++mm)
#pragma unroll
                    for (int bj = 0; bj < 2; ++bj) { const int m = 2 * mh + mm; f32x4 g0, g1, t0, t1; unpack8(sg[mm][bj], g0, g1); unpack8(tt[mm][bj], t0, t1);
                        *(u32x4*)(O + (size_t)(row0 + ai * 128 + m * 16) * 1024 + colt + bj * 128) = pack8(t0 + acc[ai][bj][m][0] * g0, t1 + acc[ai][bj][m][1] * g1); }
            }
    }
};
struct EpiF32 {
    static constexpr bool PERM = true;
    bf16_t* C0; bf16_t* C1; int ldc;
    __device__ __forceinline__ void operator()(const f32x4 (&acc)[2][2][4][2], const Unit& u, int wr, int wc, int fr, int fq) const {
        bf16_t* C = (u.pn >= 4) ? C1 : C0;
        EPI_LOOP_BEGIN
            *(u32x4*)(C + (size_t)row * ldc + (col & 1023)) = pack8(v0, v1);
        EPI_LOOP_END
    }
};
struct EpiBf16 {
    static constexpr bool PERM = true;
    bf16_t* O; int ldc;
    __device__ __forceinline__ void operator()(const f32x4 (&acc)[2][2][4][2], const Unit& u, int wr, int wc, int fr, int fq) const {
        EPI_LOOP_BEGIN
            *(u32x4*)(O + (size_t)row * ldc + col) = pack8(v0, v1);
        EPI_LOOP_END
    }
};

__device__ __forceinline__ float dpp_ror1(float v) { return __builtin_bit_cast(float, __builtin_amdgcn_update_dpp(0, __builtin_bit_cast(int, v), 0x121, 0xf, 0xf, true)); }
__device__ __forceinline__ float dpp_ror15(float v) { return __builtin_bit_cast(float, __builtin_amdgcn_update_dpp(0, __builtin_bit_cast(int, v), 0x12f, 0xf, 0xf, true)); }
struct EpiConv {
    static constexpr bool PERM = true;
    bf16_t* ACT; const float* cw; const float* cb; LAS float* X;
    __device__ __forceinline__ void operator()(const f32x4 (&acc)[2][2][4][2], const Unit& u, int wr, int wc, int fr, int fq) const {
        const bool prompt = u.pm < 16;
        const int cl = wc * 32 + 8 * fq;
        if (prompt) {
#pragma unroll
            for (int ai = 0; ai < 2; ++ai)
#pragma unroll
                for (int bj = 0; bj < 2; ++bj) { const int b = 2 * ai + wr;
                    if (fr == 0) { *(LAS f32x4*)(X + ((b * 2 + 0) * 2 + bj) * 128 + cl) = acc[ai][bj][0][0]; *(LAS f32x4*)(X + ((b * 2 + 0) * 2 + bj) * 128 + cl + 4) = acc[ai][bj][0][1]; }
                    if (fr == 15) { *(LAS f32x4*)(X + ((b * 2 + 1) * 2 + bj) * 128 + cl) = acc[ai][bj][3][0]; *(LAS f32x4*)(X + ((b * 2 + 1) * 2 + bj) * 128 + cl + 4) = acc[ai][bj][3][1]; } }
            asm volatile("s_waitcnt lgkmcnt(0)" ::: "memory");
            __builtin_amdgcn_s_barrier(); __builtin_amdgcn_s_barrier();
            asm volatile("" ::: "memory");
        }
        const int f0 = u.pn * 128 + cl;
#pragma unroll
        for (int n = 0; n < 2; ++n) {
            __builtin_amdgcn_sched_barrier(0);
            f32x4 W[2][4];
#pragma unroll
            for (int bj = 0; bj < 2; ++bj) { const int col = bj * DFF + f0 + 4 * n;
                W[bj][0] = *(const f32x4*)(cw + col); W[bj][1] = *(const f32x4*)(cw + NUP + col); W[bj][2] = *(const f32x4*)(cw + 2 * NUP + col); W[bj][3] = *(const f32x4*)(cb + col); }
#pragma unroll
            for (int ai = 0; ai < 2; ++ai) {
                const int b = 2 * ai + wr;
                const bool has_prev = prompt && b > 0, has_next = prompt && b < 3;
                f32x4 c[2][4];
#pragma unroll
                for (int bj = 0; bj < 2; ++bj) {
                    f32x4 xp = {0.f, 0.f, 0.f, 0.f}, xn = {0.f, 0.f, 0.f, 0.f};
                    if (has_prev) xp = *(const LAS f32x4*)(X + (((b - 1) * 2 + 1) * 2 + bj) * 128 + cl + 4 * n);
                    if (has_next) xn = *(const LAS f32x4*)(X + (((b + 1) * 2 + 0) * 2 + bj) * 128 + cl + 4 * n);
#pragma unroll
                    for (int m = 0; m < 4; ++m) {
                        f32x4 pv, nv; const f32x4 x = acc[ai][bj][m][n];
#pragma unroll
                        for (int j = 0; j < 4; ++j) {
                            const float pin = dpp_ror1(x[j]), pseam = (m > 0) ? dpp_ror1(acc[ai][bj][m > 0 ? m - 1 : 0][n][j]) : xp[j];
                            const float nin = dpp_ror15(x[j]), nseam = (m < 3) ? dpp_ror15(acc[ai][bj][m < 3 ? m + 1 : 3][n][j]) : xn[j];
                            pv[j] = (fr == 0) ? pseam : pin; nv[j] = (fr == 15) ? nseam : nin;
                        }
                        c[bj][m] = W[bj][0] * pv + W[bj][1] * x + W[bj][2] * nv + W[bj][3];
                    }
                }
#pragma unroll
                for (int m = 0; m < 4; ++m) { float o[4];
#pragma unroll
                    for (int j = 0; j < 4; ++j) { const float x = c[0][m][j]; o[j] = x * __builtin_amdgcn_rcpf(1.0f + __builtin_amdgcn_exp2f(-2.302208198f * (x + 0.044715f * x * x * x))) * c[1][m][j]; }
                    u32x2 ow; ow.x = cvt_pk_bf16(o[0], o[1]); ow.y = cvt_pk_bf16(o[2], o[3]);
                    *(u32x2*)(ACT + (size_t)(u.pm * 256 + ai * 128 + wr * 64 + m * 16 + fr) * DFF + f0 + 4 * n) = ow; }
                __builtin_amdgcn_sched_barrier(0);
            }
        }
    }
};
__device__ __forceinline__ void transpose_item(const float* __restrict__ W, int ldw, int csrc, int K, bf16_t* WT, int rdst, int k0, LAS float* scr, int lane) {
    float tv[32];
#pragma unroll
    for (int i = 0; i < 32; ++i) { const int kk = 2 * i + (lane >> 5); tv[i] = W[(size_t)(k0 + kk) * ldw + csrc + (lane & 31)]; }
#pragma unroll
    for (int i = 0; i < 32; ++i) { const int kk = 2 * i + (lane >> 5); scr[kk * 33 + (lane & 31)] = tv[i]; }
    asm volatile("s_waitcnt lgkmcnt(0)" ::: "memory");
    const int c = lane & 7;
#pragma unroll
    for (int j = 0; j < 4; ++j) { const int n = (lane >> 3) + 8 * j; const LAS float* s = scr + (8 * c) * 33 + n;
        u32x4 o; o.x = cvt_pk_bf16(s[0], s[33]); o.y = cvt_pk_bf16(s[66], s[99]); o.z = cvt_pk_bf16(s[132], s[165]); o.w = cvt_pk_bf16(s[198], s[231]);
        *(u32x4*)(WT + (size_t)(rdst + n) * K + k0 + 8 * c) = o; }
    asm volatile("s_waitcnt lgkmcnt(0)" ::: "memory");
}

struct TileDesc { const float* W; bf16_t* WT; int ldw, c_lo, c_hi, K, rdst, k0; };
template <int SET> __device__ __forceinline__ TileDesc tile_desc(const Params& p, int it) {
    constexpr int T_IN = 16 * 22, T_UP = 16 * 22, T_DN = 44 * 4, T_A = 16 * 4, T_O = 16 * 4;
    TileDesc d; d.W = nullptr; d.WT = nullptr; d.ldw = d.c_lo = d.c_hi = d.K = d.rdst = d.k0 = 0;
    int r = it; if (r < 0) return d;
    if (SET == 0) {
        if (r < T_IN) { const int kb = r / 22, tl = r % 22, n0 = tl * 256, cs = n0 + (tl >= 12 ? 16 : 0); d = TileDesc{p.in[13], (bf16_t*)(p.ws + OFF_WT_IN), INC, cs, cs + 128, 1024, n0, kb * 64}; return d; } r -= T_IN;
        if (r < T_UP) { const int kb = r / 22, tl = r % 22; d = TileDesc{p.in[21], (bf16_t*)(p.ws + OFF_WT_UP), NUP, tl * 128, DFF + tl * 128, 1024, tl * 256, kb * 64}; return d; }
    } else if (SET == 1) {
        if (r < T_DN) { const int kb = r / 4, tl = r % 4; d = TileDesc{p.in[24], (bf16_t*)(p.ws + OFF_WT_DOWN), 1024, tl * 256, tl * 256 + 128, DFF, tl * 256, kb * 64}; return d; }
    } else {
        if (r < T_A) { const int kb = r / 4, tl = r % 4; d = TileDesc{p.in[18], (bf16_t*)(p.ws + OFF_WT_BRA), 1024, tl * 256, tl * 256 + 128, 1024, tl * 256, kb * 64}; return d; } r -= T_A;
        if (r < T_O) { const int kb = r / 4, tl = r % 4; d = TileDesc{p.in[20], (bf16_t*)(p.ws + OFF_WT_OUT), 1024, tl * 256, tl * 256 + 128, 1024, tl * 256, kb * 64}; return d; }
    }
    return d;
}
__device__ __forceinline__ void tile_load(const TileDesc& d, f32x4 (&v)[8], int tid) {
    const int wave = tid >> 6, lane = tid & 63;
    const int scol = (lane < 32) ? d.c_lo + 4 * lane : d.c_hi + 4 * (lane - 32);
#pragma unroll
    for (int i = 0; i < 8; ++i) v[i] = __builtin_nontemporal_load((const f32x4*)(d.W + (size_t)(d.k0 + wave * 8 + i) * d.ldw + scol));
}
__device__ __forceinline__ void tile_finish(const TileDesc& d, const f32x4 (&v)[8], LAS float* tile, int tid) {
    const int wave = tid >> 6, lane = tid & 63;
#pragma unroll
    for (int i = 0; i < 8; ++i) *(LAS f32x4*)(tile + (wave * 8 + i) * 260 + 4 * (lane ^ wave)) = v[i];
    __syncthreads();
    const int c = tid & 7;
#pragma unroll
    for (int j = 0; j < 4; ++j) { const int n = (tid >> 3) + 64 * j; const LAS float* s = tile + (8 * c) * 260 + 4 * ((n >> 2) ^ c) + (n & 3);
        u32x4 o; o.x = cvt_pk_bf16(s[0], s[260]); o.y = cvt_pk_bf16(s[520], s[780]); o.z = cvt_pk_bf16(s[1040], s[1300]); o.w = cvt_pk_bf16(s[1560], s[1820]);
        *(u32x4*)(d.WT + (size_t)(d.rdst + n) * d.K + d.k0 + 8 * c) = o; }
    __syncthreads();
}

template <int SET> __device__ __forceinline__ void tile_loop(const Params& p, LAS float* L, int first, int step) {
    int tid = threadIdx.x; asm volatile("" : "+v"(tid));
    TileDesc d0 = tile_desc<SET>(p, first), d1; f32x4 va[8], vb[8];
    if (d0.W) tile_load(d0, va, tid);
    for (int it = first; d0.W; it += 2 * step) {
        d1 = tile_desc<SET>(p, it + step); if (d1.W) tile_load(d1, vb, tid);
        tile_finish(d0, va, L, tid);
        if (!d1.W) break;
        d0 = tile_desc<SET>(p, it + 2 * step); if (d0.W) tile_load(d0, va, tid);
        tile_finish(d1, vb, L, tid);
    }
}

__device__ __forceinline__ void phase0(const Params& p, LAS unsigned char* ldsb, int bid, int G) {
    const int tid = threadIdx.x, wave = tid >> 6, lane = tid & 63;
    LAS float* L = (LAS float*)ldsb;
    {
        for (int i = tid; i < 3072; i += 512) { const int ci = i >> 10, d = i & 1023; const float c = (ci == 0) ? p.in[6][d] : p.in[5][(ci - 1) * 1024 + d]; L[i] = c / (1.0f + __expf(-c)); }
        __syncthreads();
        float* MODa = (float*)(p.ws + OFF_MOD);
        for (int wi = bid * 8 + wave; wi < 768; wi += G * 8) {
            const int cgp = wi % 24, dr = wi / 24, n0 = cgp * 256 + 4 * lane;
            const float* wa = p.in[7] + (size_t)(dr * 32) * 6144 + n0;
            f32x4 a0 = {0.f, 0.f, 0.f, 0.f}, a1 = a0, a2 = a0;
            if (dr == 0) { a0 = *(const f32x4*)(p.in[8] + n0); a1 = a0; a2 = a0; }
#pragma unroll 1
            for (int d0 = 0; d0 < 32; d0 += 16) {
                f32x4 w[16];
#pragma unroll
                for (int k = 0; k < 16; ++k) w[k] = __builtin_nontemporal_load((const f32x4*)(wa + (size_t)(d0 + k) * 6144));
#pragma unroll
                for (int k = 0; k < 16; ++k) { const int dd = dr * 32 + d0 + k; a0 += w[k] * L[dd]; a1 += w[k] * L[1024 + dd]; a2 += w[k] * L[2048 + dd]; }
            }
#pragma unroll
            for (int j = 0; j < 4; ++j) { atomicAdd(MODa + n0 + j, a0[j]); atomicAdd(MODa + 6144 + n0 + j, a1[j]); atomicAdd(MODa + 12288 + n0 + j, a2[j]); }
            asm volatile("s_waitcnt vmcnt(0)" ::: "memory");
            if (lane == 0) __hip_atomic_fetch_add((unsigned*)(p.ws + OFF_MODCNT), 1u, __ATOMIC_RELAXED, __HIP_MEMORY_SCOPE_AGENT);
        }
        __syncthreads();
    }
    for (int item = G - 1 - bid; item < 128; item += G) {
        const int gi = item >> 5, d0 = (item & 31) * 32;
        LAS float* Wp = L; LAS float* Wb = L + 128 * 129;
        const float* wp = p.in[16] + gi * 16384; const float* wb = p.in[19] + (size_t)(gi * 128) * 1024 + d0; const float* ps = p.in[17] + gi * 128;
        for (int i = tid; i < 16384; i += 512) { const int c = i >> 7, j = i & 127; Wp[c * 129 + j] = wp[i]; }
        for (int i = tid; i < 4096; i += 512) { const int j = i >> 5, dd = i & 31; Wb[i] = wb[(size_t)j * 1024 + dd] * ps[j]; }
        __syncthreads();
        const int c = tid & 127, dq = tid >> 7;
        float acc[8];
#pragma unroll
        for (int e = 0; e < 8; ++e) acc[e] = 0.f;
        for (int j = 0; j < 128; ++j) { const float a = Wp[c * 129 + j]; const f32x4 b0 = *(const LAS f32x4*)(Wb + j * 32 + dq * 8), b1 = *(const LAS f32x4*)(Wb + j * 32 + dq * 8 + 4);
            acc[0] += a * b0.x; acc[1] += a * b0.y; acc[2] += a * b0.z; acc[3] += a * b0.w; acc[4] += a * b1.x; acc[5] += a * b1.y; acc[6] += a * b1.z; acc[7] += a * b1.w; }
        bf16_t* we = (bf16_t*)(p.ws + OFF_WT_EFF);
#pragma unroll
        for (int e = 0; e < 8; ++e) we[(size_t)(d0 + dq * 8 + e) * 512 + gi * 128 + c] = (bf16_t)(cvt_pk_bf16(acc[e], 0.f) & 0xffffu);
        __syncthreads();
    }
    tile_loop<0>(p, L, bid, G);
}

__device__ __forceinline__ void phase_norm1(const Params& p, LAS unsigned char* ldsb, int bid, int G) {
    const int tid = threadIdx.x, wave = tid >> 6, lane = tid & 63;
    LAS float* Wg = (LAS float*)ldsb;
    const float* w_in = p.in[13];
    for (int i = tid; i < 4096; i += 512) { const int d = i >> 2, q = i & 3; const f32x4 v = *(const f32x4*)(w_in + (size_t)d * INC + 3072 + 4 * q);
        Wg[(4 * q + 0) * 1024 + d] = v.x; Wg[(4 * q + 1) * 1024 + d] = v.y; Wg[(4 * q + 2) * 1024 + d] = v.z; Wg[(4 * q + 3) * 1024 + d] = v.w; }
    if (tid == 0) {
        unsigned* cnt = (unsigned*)(p.ws + OFF_MODCNT); unsigned sp = 0;
        while (__hip_atomic_load(cnt, __ATOMIC_RELAXED, __HIP_MEMORY_SCOPE_AGENT) < 768u && ++sp < (1u << 22)) __builtin_amdgcn_s_sleep(2);
        __builtin_amdgcn_fence(__ATOMIC_ACQUIRE, "agent");
        asm volatile("s_waitcnt vmcnt(0)" ::: "memory");
    }
    __syncthreads();
    const float* MOD = (const float*)(p.ws + OFF_MOD); float* GATES = (float*)(p.ws + OFF_GATES); bf16_t* H1 = (bf16_t*)(p.ws + OFF_H1);
    const float* gpre = p.in[9]; const float* bg = p.in[14];
    for (int row0 = 2 * (bid * 8 + wave); row0 < NTOK; row0 += 2 * G * 8) {
        const float* x = row0 < NPROMPT ? p.in[0] + (size_t)row0 * 1024 : p.in[1] + (size_t)(row0 - NPROMPT) * 1024;
        const int ci = row0 < NPROMPT ? 0 : 1 + ((row0 - NPROMPT) >> 11);
        const float* md = MOD + ci * 6144;
        f32x4 xq[2][4], gv[4], shv[4], scv[4];
#pragma unroll
        for (int j = 0; j < 4; ++j) { const int o = 256 * j + 4 * lane; xq[0][j] = *(const f32x4*)(x + o); xq[1][j] = *(const f32x4*)(x + 1024 + o); gv[j] = *(const f32x4*)(gpre + o); shv[j] = *(const f32x4*)(md + o); scv[j] = *(const f32x4*)(md + 1024 + o); }
#pragma unroll
        for (int q = 0; q < 2; ++q) {
            const int row = row0 + q; float ss = 0.f;
#pragma unroll
            for (int j = 0; j < 4; ++j) ss += xq[q][j].x * xq[q][j].x + xq[q][j].y * xq[q][j].y + xq[q][j].z * xq[q][j].z + xq[q][j].w * xq[q][j].w;
            ss = wave_sum(ss); const float rstd = rsqrtf(ss * (1.0f / 1024.0f) + EPSN);
            f32x4 hv[4];
#pragma unroll
            for (int j = 0; j < 4; ++j) { const int o = 256 * j + 4 * lane;
                hv[j] = (xq[q][j] * rstd) * gv[j] * (scv[j] + 1.0f) + shv[j];
                u32x2 w; w.x = cvt_pk_bf16(hv[j].x, hv[j].y); w.y = cvt_pk_bf16(hv[j].z, hv[j].w); *(u32x2*)(H1 + (size_t)row * 1024 + o) = w; }
            float gvv[16];
#pragma unroll
            for (int g = 0; g < 16; ++g) { float a = 0.f;
                if ((g & 3) == 0) __builtin_amdgcn_sched_barrier(0);
#pragma unroll
                for (int j = 0; j < 4; ++j) { const f32x4 w = *(const LAS f32x4*)(Wg + g * 1024 + 256 * j + 4 * lane); a += hv[j].x * w.x + hv[j].y * w.y + hv[j].z * w.z + hv[j].w * w.w; }
                gvv[g] = a; }
            { const bool b0 = lane & 1, b1 = lane & 2, b2 = lane & 4, b3 = lane & 8;
#pragma unroll
              for (int i = 0; i < 8; ++i) { const float send = b0 ? gvv[i] : gvv[8 + i], keep = b0 ? gvv[8 + i] : gvv[i];
                  gvv[i] = keep + __builtin_bit_cast(float, __builtin_amdgcn_update_dpp(0, __builtin_bit_cast(int, send), 0xB1, 0xf, 0xf, true)); }
#pragma unroll
              for (int i = 0; i < 4; ++i) { const float send = b1 ? gvv[i] : gvv[4 + i], keep = b1 ? gvv[4 + i] : gvv[i];
                  gvv[i] = keep + __builtin_bit_cast(float, __builtin_amdgcn_update_dpp(0, __builtin_bit_cast(int, send), 0x4E, 0xf, 0xf, true)); }
#pragma unroll
              for (int i = 0; i < 2; ++i) { const float send = b2 ? gvv[i] : gvv[2 + i], keep = b2 ? gvv[2 + i] : gvv[i]; gvv[i] = keep + __shfl_xor(send, 4); }
              { const float send = b3 ? gvv[0] : gvv[1], keep = b3 ? gvv[1] : gvv[0]; gvv[0] = keep + __shfl_xor(send, 8); }
              gvv[0] += __shfl_xor(gvv[0], 16); gvv[0] += __shfl_xor(gvv[0], 32); }
            if (lane < 16) { const int g = ((lane & 1) << 3) | ((lane & 2) << 1) | ((lane & 4) >> 1) | ((lane & 8) >> 3);
                const float z = gvv[0] + bg[g]; const float o = g < 8 ? z : (fminf(z, 0.f) - log1pf(__expf(-fabsf(z)))); GATES[(size_t)row * 16 + g] = o; }
        }
    }
}

__device__ __forceinline__ bf16x8 scale8(bf16x8 v, const float (&s)[8]) {
    const u32x4 w = __builtin_bit_cast(u32x4, v); u32x4 o;
    o.x = cvt_pk_bf16(bf_lo(w.x) * s[0], bf_hi(w.x) * s[1]); o.y = cvt_pk_bf16(bf_lo(w.y) * s[2], bf_hi(w.y) * s[3]);
    o.z = cvt_pk_bf16(bf_lo(w.z) * s[4], bf_hi(w.z) * s[5]); o.w = cvt_pk_bf16(bf_lo(w.w) * s[6], bf_hi(w.w) * s[7]);
    return __builtin_bit_cast(bf16x8, o);
}
__device__ __forceinline__ bf16x8 scale8u(bf16x8 v, float s) {
    const u32x4 w = __builtin_bit_cast(u32x4, v); u32x4 o;
    o.x = cvt_pk_bf16(bf_lo(w.x) * s, bf_hi(w.x) * s); o.y = cvt_pk_bf16(bf_lo(w.y) * s, bf_hi(w.y) * s);
    o.z = cvt_pk_bf16(bf_lo(w.z) * s, bf_hi(w.z) * s); o.w = cvt_pk_bf16(bf_lo(w.w) * s, bf_hi(w.w) * s);
    return __builtin_bit_cast(bf16x8, o);
}
__device__ __forceinline__ float wave_max(float v) {
#pragma unroll
    for (int o = 1; o < 64; o <<= 1) v = fmaxf(v, __shfl_xor(v, o));
    return v;
}
__device__ __forceinline__ float prefix_sum64(float v, int lane) {
#pragma unroll
    for (int o = 1; o < 64; o <<= 1) { const float t = __shfl_up(v, o); if (lane >= o) v += t; }
    return v;
}
__device__ __forceinline__ float suffix_sum64(float v, int lane) {
#pragma unroll
    for (int o = 1; o < 64; o <<= 1) { const float t = __shfl_down(v, o); if (lane + o < 64) v += t; }
    return v;
}
__device__ __forceinline__ float prefix_max64(float v, int lane) {
#pragma unroll
    for (int o = 1; o < 64; o <<= 1) { const float t = __shfl_up(v, o); if (lane >= o) v = fmaxf(v, t); }
    return v;
}
__device__ __forceinline__ float suffix_max64(float v, int lane) {
#pragma unroll
    for (int o = 1; o < 64; o <<= 1) { const float t = __shfl_down(v, o); if (lane + o < 64) v = fmaxf(v, t); }
    return v;
}

template <int HALFW> __device__ __forceinline__ void pool_task(const bf16_t* U, bf16_t* DP, int r, int t, int cols, int base, int ch0) {
    u32x4 w[2 * HALFW];
#pragma unroll
    for (int k = 0; k < 2 * HALFW; ++k) { const int tt = t - HALFW + k, tc = min(max(tt, 0), cols - 1); w[k] = *(const u32x4*)(U + (size_t)(base + tc) * 512 + ch0); }
    float s[8];
#pragma unroll
    for (int e = 0; e < 8; ++e) s[e] = 0.f;
#pragma unroll
    for (int k = 0; k < 2 * HALFW; ++k) { const int tt = t - HALFW + k; const float m = (tt >= 0 && tt < cols) ? 1.0f : 0.0f;
        s[0] += m * bf_lo(w[k].x); s[1] += m * bf_hi(w[k].x); s[2] += m * bf_lo(w[k].y); s[3] += m * bf_hi(w[k].y); s[4] += m * bf_lo(w[k].z); s[5] += m * bf_hi(w[k].z); s[6] += m * bf_lo(w[k].w); s[7] += m * bf_hi(w[k].w); }
    const int lo = max(t - HALFW, 0), hi = min(t + HALFW, cols);
    const float inv = 1.0f / (float)(hi - lo);
    const u32x4 c = w[HALFW]; u32x4 o;
    o.x = cvt_pk_bf16(s[0] * inv - bf_lo(c.x), s[1] * inv - bf_hi(c.x)); o.y = cvt_pk_bf16(s[2] * inv - bf_lo(c.y), s[3] * inv - bf_hi(c.y));
    o.z = cvt_pk_bf16(s[4] * inv - bf_lo(c.z), s[5] * inv - bf_hi(c.z)); o.w = cvt_pk_bf16(s[6] * inv - bf_lo(c.w), s[7] * inv - bf_hi(c.w));
    *(u32x4*)(DP + (size_t)r * 512 + ch0) = o;
}

__device__ __forceinline__ void phase_chunk(const Params& p, LAS unsigned char* ldsb, int bid, int G) {
    const int tid = threadIdx.x, wave = tid >> 6, lane = tid & 63, fr = lane & 15, fq = lane >> 4;
    LAS float* ew = (LAS float*)ldsb;
    const float* GATES = (const float*)(p.ws + OFF_GATES);
    const bf16_t* KT = (const bf16_t*)(p.ws + OFF_KT); const bf16_t* VT = (const bf16_t*)(p.ws + OFF_VT);
    bf16_t* KV = (bf16_t*)(p.ws + OFF_KV); float* NCH = (float*)(p.ws + OFF_NCH); float* WMAX = (float*)(p.ws + OFF_WMAX); float* BLAST = (float*)(p.ws + OFF_BLAST);
    for (int item = 256 + bid; item < 512; item += G) {
        const int cgi = item >> 2, h = item & 3, r0 = cgi * 64;
        const int idx0 = cgi * 4 + h, idx1 = (128 + cgi) * 4 + h;
        __syncthreads();
        if (wave == 0) {
            const float* gp = GATES + (size_t)(r0 + lane) * 16;
            const float li0 = gp[h], li1 = gp[4 + h], lf0 = gp[8 + h], lf1 = gp[12 + h];
            const float bf = prefix_sum64(lf0, lane), bb = suffix_sum64(lf1, lane);
            const float totf = __shfl(bf, 63), totb = __shfl(bb, 0);
            const float wf = totf - bf + li0, wb = totb - bb + li1;
            const float wmf = wave_max(wf), wmb = wave_max(wb);
            ew[lane] = __expf(wf - wmf); ew[64 + lane] = __expf(wb - wmb);
            if (lane == 0) { WMAX[idx0] = wmf; BLAST[idx0] = totf; WMAX[idx1] = wmb; BLAST[idx1] = totb; }
        }
        __syncthreads();
        if (tid < 256) {
            const int dir = tid >> 7, kd = tid & 127; const bf16_t* kp = KT + (size_t)(h * 128 + kd) * NTOK + r0; float a = 0.f;
#pragma unroll
            for (int i = 0; i < 8; ++i) { const u32x4 w = *(const u32x4*)(kp + 8 * i); const LAS float* e = ew + dir * 64 + 8 * i;
                a += bf_lo(w.x) * e[0] + bf_hi(w.x) * e[1] + bf_lo(w.y) * e[2] + bf_hi(w.y) * e[3] + bf_lo(w.z) * e[4] + bf_hi(w.z) * e[5] + bf_lo(w.w) * e[6] + bf_hi(w.w) * e[7]; }
            NCH[(size_t)(dir ? idx1 : idx0) * 128 + kd] = a;
        }
        bf16x8 vf[2][2];
#pragma unroll
        for (int mb = 0; mb < 2; ++mb)
#pragma unroll
            for (int ks = 0; ks < 2; ++ks) vf[mb][ks] = *(const bf16x8*)(VT + (size_t)(h * 256 + 32 * wave + 16 * mb + fr) * NTOK + r0 + 32 * ks + 8 * fq);
        float ewl[2][2][8];
#pragma unroll
        for (int dir = 0; dir < 2; ++dir)
#pragma unroll
            for (int ks = 0; ks < 2; ++ks)
#pragma unroll
                for (int e = 0; e < 8; ++e) ewl[dir][ks][e] = ew[dir * 64 + 32 * ks + 8 * fq + e];
        bf16x8 kfa[8][2];
#pragma unroll
        for (int nb = 0; nb < 8; ++nb)
#pragma unroll
            for (int ks = 0; ks < 2; ++ks) kfa[nb][ks] = *(const bf16x8*)(KT + (size_t)(h * 128 + 16 * nb + fr) * NTOK + r0 + 32 * ks + 8 * fq);
#pragma unroll
        for (int nb = 0; nb < 8; ++nb) {
#pragma unroll
            for (int dir = 0; dir < 2; ++dir) {
                f32x4 a0 = {0.f, 0.f, 0.f, 0.f}, a1 = {0.f, 0.f, 0.f, 0.f};
#pragma unroll
                for (int ks = 0; ks < 2; ++ks) { const bf16x8 kk = scale8(kfa[nb][ks], ewl[dir][ks]);
                    a0 = __builtin_amdgcn_mfma_f32_16x16x32_bf16(kk, vf[0][ks], a0, 0, 0, 0); a1 = __builtin_amdgcn_mfma_f32_16x16x32_bf16(kk, vf[1][ks], a1, 0, 0, 0); }
                bf16_t* o = KV + (size_t)(dir ? idx1 : idx0) * 32768 + (size_t)(32 * wave + fr) * 128 + 16 * nb + 4 * fq;
                u32x2 w0, w1; w0.x = cvt_pk_bf16(a0[0], a0[1]); w0.y = cvt_pk_bf16(a0[2], a0[3]); w1.x = cvt_pk_bf16(a1[0], a1[1]); w1.y = cvt_pk_bf16(a1[2], a1[3]);
                *(u32x2*)o = w0; *(u32x2*)(o + 16 * 128) = w1;
            }
        }
    }
    const bf16_t* U = (const bf16_t*)(p.ws + OFF_U); bf16_t* DP = (bf16_t*)(p.ws + OFF_DP);
    for (int wt = bid * 8 + wave; wt < 8192; wt += G * 8) {
        const int gi = wt & 3, r = (wt >> 2) * 4 + (lane >> 4), ch0 = gi * 128 + (lane & 15) * 8;
        int t, cols; if (r < NPROMPT) { t = r & 255; cols = 256; } else { t = (r - NPROMPT) & 63; cols = 64; }
        const int base = r - t;
        switch (gi) {
            case 0: pool_task<1>(U, DP, r, t, cols, base, ch0); break;
            case 1: pool_task<2>(U, DP, r, t, cols, base, ch0); break;
            case 2: pool_task<4>(U, DP, r, t, cols, base, ch0); break;
            default: pool_task<8>(U, DP, r, t, cols, base, ch0); break;
        }
    }
}

__device__ __forceinline__ void phase_prompt_final(const Params& p, LAS unsigned char* ldsb, int bid, int G) {
    int tid = threadIdx.x; asm volatile("" : "+v"(tid));
    const int wave = tid >> 6, lane = tid & 63, fr = lane & 15, fq = lane >> 4;
    LAS float* EW = (LAS float*)ldsb;
    LAS float* SC = EW + 256;
    LAS float* Ct = (LAS float*)(ldsb + 2048);
    const float* GATES = (const float*)(p.ws + OFF_GATES); const bf16_t* KT = (const bf16_t*)(p.ws + OFF_KT); const bf16_t* VT = (const bf16_t*)(p.ws + OFF_VT);
    for (int item = bid; item < 256; item += G) {
        const int sb = item >> 1, half = item & 1, b = sb >> 3, dir = (sb >> 2) & 1, h = sb & 3, r0 = b * 256, gcol = dir * 4 + h;
        __syncthreads();
        float wloc = 0.f;
        if (wave < 4) { const float* gp = GATES + (size_t)(r0 + 64 * wave + lane) * 16; const float li = gp[gcol], lf = gp[8 + gcol];
            const float cum = dir ? suffix_sum64(lf, lane) : prefix_sum64(lf, lane), tot = dir ? __shfl(cum, 0) : __shfl(cum, 63);
            if (lane == 0) SC[wave] = tot;
            wloc = li - cum; }
        __syncthreads();
        if (wave < 4) { float off = 0.f, bt = 0.f;
#pragma unroll
            for (int w2 = 0; w2 < 4; ++w2) { const float t = SC[w2]; bt += t; if (dir ? (w2 > wave) : (w2 < wave)) off += t; }
            const float wv = wloc + (bt - off), wm = wave_max(wv);
            EW[64 * wave + lane] = wv;
            if (lane == 0) { SC[4 + wave] = wm; SC[12] = bt; } }
        __syncthreads();
        const float wmax = fmaxf(fmaxf(SC[4], SC[5]), fmaxf(SC[6], SC[7])), btot = SC[12];
        const float mfin = fmaxf(btot, wmax), g = __expf(wmax - mfin);
        __syncthreads();
        if (tid < 256) EW[tid] = __expf(EW[tid] - wmax);
        __syncthreads();
        f32x4 C[8];
#pragma unroll
        for (int nb = 0; nb < 8; ++nb) C[nb] = (f32x4){0.f, 0.f, 0.f, 0.f};
        const int vrow = 128 * half + 16 * wave + fr;
#pragma unroll 2
        for (int ks = 0; ks < 8; ++ks) {
            const bf16x8 vf = *(const bf16x8*)(VT + (size_t)(h * 256 + vrow) * NTOK + r0 + 32 * ks + 8 * fq);
            const f32x4 e0 = *(const LAS f32x4*)(EW + 32 * ks + 8 * fq), e1 = *(const LAS f32x4*)(EW + 32 * ks + 8 * fq + 4);
            const float e8[8] = {e0.x, e0.y, e0.z, e0.w, e1.x, e1.y, e1.z, e1.w};
#pragma unroll
            for (int nb = 0; nb < 8; ++nb) { const bf16x8 kk = scale8(*(const bf16x8*)(KT + (size_t)(h * 128 + 16 * nb + fr) * NTOK + r0 + 32 * ks + 8 * fq), e8);
                C[nb] = __builtin_amdgcn_mfma_f32_16x16x32_bf16(kk, vf, C[nb], 0, 0, 0); }
        }
#pragma unroll
        for (int nb = 0; nb < 8; ++nb) *(LAS f32x4*)(Ct + (16 * wave + fr) * 132 + 16 * nb + 4 * fq) = C[nb] * g;
        if (half == 0 && tid < 128) { const bf16_t* kp = KT + (size_t)(h * 128 + tid) * NTOK + r0; float a = 0.f;
#pragma unroll 8
            for (int i = 0; i < 32; ++i) { const u32x4 w = *(const u32x4*)(kp + 8 * i); const LAS float* e = EW + 8 * i;
                a += bf_lo(w.x) * e[0] + bf_hi(w.x) * e[1] + bf_lo(w.y) * e[2] + bf_hi(w.y) * e[3] + bf_lo(w.z) * e[4] + bf_hi(w.z) * e[5] + bf_lo(w.w) * e[6] + bf_hi(w.w) * e[7]; }
            p.out[OUT_N + sb * 128 + tid] = g * a; if (tid == 0) p.out[OUT_M + sb] = mfin; }
        __syncthreads();
        { float* oc = p.out + OUT_C + (size_t)sb * 32768 + half * 128;
#pragma unroll
          for (int k = 0; k < 8; ++k) { const int q = tid + 512 * k, kd = q >> 5, v4 = (q & 31) * 4;
              const f32x4 o = {Ct[(v4 + 0) * 132 + kd], Ct[(v4 + 1) * 132 + kd], Ct[(v4 + 2) * 132 + kd], Ct[(v4 + 3) * 132 + kd]};
              __builtin_nontemporal_store(o, (f32x4*)(oc + (size_t)kd * 256 + v4)); } }
    }
}
struct SeqInfo { int sb, dir, h, nc, cg0, sample; };
__device__ __forceinline__ SeqInfo seq_info(int sidx) {
    SeqInfo s; int b;
    if (sidx < 16) { s.sample = 1; b = sidx >> 3; s.dir = (sidx >> 2) & 1; s.h = sidx & 3; s.nc = 32; s.cg0 = 64 + 32 * b; }
    else { const int q = sidx - 16; s.sample = 0; b = q >> 3; s.dir = (q >> 2) & 1; s.h = q & 3; s.nc = 4; s.cg0 = 4 * b; }
    s.sb = (b * 2 + s.dir) * 4 + s.h; return s;
}
__device__ __forceinline__ void unpack4(const u32x2& w, float (&f)[4]) { f[0] = bf_lo(w.x); f[1] = bf_hi(w.x); f[2] = bf_lo(w.y); f[3] = bf_hi(w.y); }
__device__ __forceinline__ void unpack8f(const u32x4& w, float (&f)[8]) { f[0] = bf_lo(w.x); f[1] = bf_hi(w.x); f[2] = bf_lo(w.y); f[3] = bf_hi(w.y); f[4] = bf_lo(w.z); f[5] = bf_hi(w.z); f[6] = bf_lo(w.w); f[7] = bf_hi(w.w); }

__device__ __forceinline__ void phase_scan(const Params& p, LAS unsigned char* ldsb, int bid, int G) {
    const int tid = threadIdx.x;
    LAS float* SA = (LAS float*)ldsb;
    LAS float* Ct = (LAS float*)(ldsb + 1024);
    bf16_t* KV = (bf16_t*)(p.ws + OFF_KV); float* NCH = (float*)(p.ws + OFF_NCH); const float* WMAX = (const float*)(p.ws + OFF_WMAX); const float* BLAST = (const float*)(p.ws + OFF_BLAST); float* MS = (float*)(p.ws + OFF_MS);
    for (int bt = bid; bt < 256; bt += G) {
        {
            const SeqInfo s = seq_info(bt >> 4); const int part = bt & 15;
            const int e0 = (part * 512 + tid) * 4, v = e0 >> 7, kd0 = e0 & 127;
            __syncthreads();
            if (tid < 32) { const int c = s.dir ? 31 - tid : tid, idx = (s.dir * 128 + s.cg0 + c) * 4 + s.h; SA[128 + tid] = BLAST[idx]; SA[160 + tid] = WMAX[idx]; }
            float C[4];
            { const float* c0 = p.in[2] + ((size_t)s.sb * 128 + kd0) * 256 + v;
#pragma unroll
              for (int e = 0; e < 4; ++e) C[e] = c0[(size_t)e * 256]; }
            u32x2 kv[16];
#pragma unroll
            for (int i = 0; i < 16; ++i) { const int c = s.dir ? 31 - i : i, idx = (s.dir * 128 + s.cg0 + c) * 4 + s.h; kv[i] = *(const u32x2*)(KV + (size_t)idx * 32768 + e0); }
            __syncthreads();
            if (tid == 0) { float m = p.in[4][s.sb];
                for (int i = 0; i < 32; ++i) { const float bl = SA[128 + i], wm = SA[160 + i], mn = fmaxf(m + bl, wm); SA[i] = __expf(m + bl - mn); SA[32 + i] = __expf(wm - mn); SA[64 + i] = m; m = mn; }
                SA[96] = m; }
            __syncthreads();
#pragma unroll 1
            for (int hh = 0; hh < 2; ++hh) {
                if (hh == 1) {
#pragma unroll
                    for (int i = 0; i < 16; ++i) { const int c = s.dir ? 15 - i : 16 + i, idx = (s.dir * 128 + s.cg0 + c) * 4 + s.h; kv[i] = *(const u32x2*)(KV + (size_t)idx * 32768 + e0); }
                }
#pragma unroll
                for (int i = 0; i < 16; ++i) { const float a = SA[hh * 16 + i], g = SA[32 + hh * 16 + i]; float f[4]; unpack4(kv[i], f);
                    kv[i].x = cvt_pk_bf16(C[0], C[1]); kv[i].y = cvt_pk_bf16(C[2], C[3]);
#pragma unroll
                    for (int e = 0; e < 4; ++e) C[e] = a * C[e] + g * f[e]; }
#pragma unroll
                for (int i = 0; i < 16; ++i) { const int ii = hh * 16 + i, c = s.dir ? 31 - ii : ii, idx = (s.dir * 128 + s.cg0 + c) * 4 + s.h; *(u32x2*)(KV + (size_t)idx * 32768 + e0) = kv[i]; }
            }
            if (part == 0 && tid < 128) {
                float n = p.in[3][s.sb * 128 + tid];
#pragma unroll 1
                for (int hh = 0; hh < 2; ++hh) {
                    float nv[16];
#pragma unroll
                    for (int i = 0; i < 16; ++i) { const int ii = hh * 16 + i, c = s.dir ? 31 - ii : ii, idx = (s.dir * 128 + s.cg0 + c) * 4 + s.h; nv[i] = NCH[(size_t)idx * 128 + tid]; }
#pragma unroll
                    for (int i = 0; i < 16; ++i) { const float t = nv[i]; nv[i] = n; n = SA[hh * 16 + i] * n + SA[32 + hh * 16 + i] * t; }
#pragma unroll
                    for (int i = 0; i < 16; ++i) { const int ii = hh * 16 + i, c = s.dir ? 31 - ii : ii, idx = (s.dir * 128 + s.cg0 + c) * 4 + s.h; NCH[(size_t)idx * 128 + tid] = nv[i]; if (tid == 0) MS[idx] = SA[64 + ii]; }
                }
            }
        }
        if (false) {
            const SeqInfo s = seq_info(16 + (bt >> 1)); const int half = bt & 1;
            __syncthreads();
            if (tid < 4) { const int c = s.dir ? 3 - tid : tid, idx = (s.dir * 128 + s.cg0 + c) * 4 + s.h; SA[128 + tid] = BLAST[idx]; SA[160 + tid] = WMAX[idx]; }
            __syncthreads();
            if (tid == 0) { float m = 0.f;
                for (int i = 0; i < 4; ++i) { const float bl = SA[128 + i], wm = SA[160 + i], mn = fmaxf(m + bl, wm); SA[i] = __expf(m + bl - mn); SA[32 + i] = __expf(wm - mn); SA[64 + i] = m; m = mn; }
                SA[96] = m; }
            __syncthreads();
            u32x4 kva[4][4];
#pragma unroll
            for (int j = 0; j < 4; ++j)
#pragma unroll
                for (int i = 0; i < 4; ++i) { const int c = s.dir ? 3 - i : i, idx = (s.dir * 128 + s.cg0 + c) * 4 + s.h; kva[j][i] = *(const u32x4*)(KV + (size_t)idx * 32768 + (size_t)(half * 2048 + tid + 512 * j) * 8); }
#pragma unroll
            for (int j = 0; j < 4; ++j) {
                u32x4 (&kvj)[4] = kva[j];
                float C[8];
#pragma unroll
                for (int e = 0; e < 8; ++e) C[e] = 0.f;
#pragma unroll
                for (int i = 0; i < 4; ++i) { const float a = SA[i], g = SA[32 + i]; float f[8]; unpack8f(kvj[i], f);
                    kvj[i].x = cvt_pk_bf16(C[0], C[1]); kvj[i].y = cvt_pk_bf16(C[2], C[3]); kvj[i].z = cvt_pk_bf16(C[4], C[5]); kvj[i].w = cvt_pk_bf16(C[6], C[7]);
#pragma unroll
                    for (int e = 0; e < 8; ++e) C[e] = a * C[e] + g * f[e]; }
#pragma unroll
                for (int i = 0; i < 4; ++i) { const int c = s.dir ? 3 - i : i, idx = (s.dir * 128 + s.cg0 + c) * 4 + s.h; *(u32x4*)(KV + (size_t)idx * 32768 + (size_t)(half * 2048 + tid + 512 * j) * 8) = kvj[i]; }
                LAS float* cp = Ct + (32 * j + (tid >> 4)) * 132 + (tid & 15) * 8;
                *(LAS f32x4*)cp = (f32x4){C[0], C[1], C[2], C[3]}; *(LAS f32x4*)(cp + 4) = (f32x4){C[4], C[5], C[6], C[7]};
            }
            __syncthreads();
            {
                float* oc = p.out + OUT_C + (size_t)s.sb * 32768 + half * 128;
#pragma unroll
                for (int k = 0; k < 8; ++k) { const int q = tid + 512 * k, kd = q >> 5, v4 = (q & 31) * 4;
                    const f32x4 o = {Ct[(v4 + 0) * 132 + kd], Ct[(v4 + 1) * 132 + kd], Ct[(v4 + 2) * 132 + kd], Ct[(v4 + 3) * 132 + kd]};
                    *(f32x4*)(oc + (size_t)kd * 256 + v4) = o; }
            }
            if (half == 0 && tid < 128) {
                float nv[4];
#pragma unroll
                for (int i = 0; i < 4; ++i) { const int c = s.dir ? 3 - i : i, idx = (s.dir * 128 + s.cg0 + c) * 4 + s.h; nv[i] = NCH[(size_t)idx * 128 + tid]; }
                float n = 0.f;
#pragma unroll
                for (int i = 0; i < 4; ++i) { const float t = nv[i]; nv[i] = n; n = SA[i] * n + SA[32 + i] * t; }
#pragma unroll
                for (int i = 0; i < 4; ++i) { const int c = s.dir ? 3 - i : i, idx = (s.dir * 128 + s.cg0 + c) * 4 + s.h; NCH[(size_t)idx * 128 + tid] = nv[i]; if (tid == 0) MS[idx] = SA[64 + i]; }
                p.out[OUT_N + s.sb * 128 + tid] = n; if (tid == 0) p.out[OUT_M + s.sb] = SA[96];
            }
        }
    }
}

__device__ __forceinline__ void phase_out(const Params& p, LAS unsigned char* ldsb, int bid, int G) {
    const int tid = threadIdx.x, wave = tid >> 6, lane = tid & 63, fr = lane & 15, fq = lane >> 4;
    LAS float* L = (LAS float*)ldsb;
    enum { COLF = 0, ROWF = 64, SCF = 128, EMF = 192, COLB = 256, ROWB = 320, SCB = 384, EMB = 448, RSF = 512, RSB = 576, QNF = 640, QNB = 704, CF = 768, CB = 832, SSQ = 896 };
    LAS bf16_t* Pp = (LAS bf16_t*)(ldsb + 4096);
    const float* GATES = (const float*)(p.ws + OFF_GATES); const float* MS = (const float*)(p.ws + OFF_MS); const float* NS = (const float*)(p.ws + OFF_NCH);
    const bf16_t* Q = (const bf16_t*)(p.ws + OFF_Q); const bf16_t* Kn = (const bf16_t*)(p.ws + OFF_KN); const bf16_t* VT = (const bf16_t*)(p.ws + OFF_VT);
    const bf16_t* CS = (const bf16_t*)(p.ws + OFF_KV); const bf16_t* SO = (const bf16_t*)(p.ws + OFF_SO); bf16_t* HM = (bf16_t*)(p.ws + OFF_HM);
    const float* ghead = p.in[15];
    for (int item = 256 + bid; item < 512; item += G) {
        const int cgi = item >> 2, h = item & 3, r0 = cgi * 64, idxf = cgi * 4 + h, idxb = (128 + cgi) * 4 + h;
        __syncthreads();
        if (wave == 0) {
            const float* gp = GATES + (size_t)(r0 + lane) * 16;
            const float li0 = gp[h], li1 = gp[4 + h], lf0 = gp[8 + h], lf1 = gp[12 + h], msf = MS[idxf], msb = MS[idxb];
            const float bf = prefix_sum64(lf0, lane), colf = li0 - bf, mxf = fmaxf(msf, prefix_max64(colf, lane));
            L[COLF + lane] = colf; L[ROWF + lane] = -mxf; L[SCF + lane] = __expf(msf - mxf); L[EMF + lane] = __expf(-(bf + mxf));
            const float bb = suffix_sum64(lf1, lane), colb = li1 - bb, mxb = fmaxf(msb, suffix_max64(colb, lane));
            L[COLB + lane] = colb; L[ROWB + lane] = -mxb; L[SCB + lane] = __expf(msb - mxb); L[EMB + lane] = __expf(-(bb + mxb));
            L[RSF + lane] = 0.f; L[RSB + lane] = 0.f; L[SSQ + lane] = 0.f;
        }
        {
            const int t = tid >> 3, part = tid & 7;
            const bf16_t* qp = Q + (size_t)(r0 + t) * 512 + h * 128 + 16 * part;
            const u32x4 w0 = *(const u32x4*)qp, w1 = *(const u32x4*)(qp + 8);
            float qv[16] = {bf_lo(w0.x), bf_hi(w0.x), bf_lo(w0.y), bf_hi(w0.y), bf_lo(w0.z), bf_hi(w0.z), bf_lo(w0.w), bf_hi(w0.w),
                            bf_lo(w1.x), bf_hi(w1.x), bf_lo(w1.y), bf_hi(w1.y), bf_lo(w1.z), bf_hi(w1.z), bf_lo(w1.w), bf_hi(w1.w)};
            const float* nf = NS + (size_t)idxf * 128 + 16 * part; const float* nb = NS + (size_t)idxb * 128 + 16 * part;
            float df = 0.f, db = 0.f;
#pragma unroll
            for (int e4 = 0; e4 < 4; ++e4) { const f32x4 a = *(const f32x4*)(nf + 4 * e4), b = *(const f32x4*)(nb + 4 * e4);
                df += qv[4 * e4] * a.x + qv[4 * e4 + 1] * a.y + qv[4 * e4 + 2] * a.z + qv[4 * e4 + 3] * a.w;
                db += qv[4 * e4] * b.x + qv[4 * e4 + 1] * b.y + qv[4 * e4 + 2] * b.z + qv[4 * e4 + 3] * b.w; }
            df += __shfl_xor(df, 1); df += __shfl_xor(df, 2); df += __shfl_xor(df, 4);
            db += __shfl_xor(db, 1); db += __shfl_xor(db, 2); db += __shfl_xor(db, 4);
            if (part == 0) { L[QNF + t] = df; L[QNB + t] = db; }
        }
        const int mb = wave >> 1, nb0 = 2 * (wave & 1);
        f32x4 S[2] = {{0.f, 0.f, 0.f, 0.f}, {0.f, 0.f, 0.f, 0.f}};
        {
            bf16x8 qf[4];
#pragma unroll
            for (int ks = 0; ks < 4; ++ks) qf[ks] = *(const bf16x8*)(Q + (size_t)(r0 + 16 * mb + fr) * 512 + h * 128 + 32 * ks + 8 * fq);
#pragma unroll
            for (int n2 = 0; n2 < 2; ++n2)
#pragma unroll
                for (int ks = 0; ks < 4; ++ks) { const bf16x8 kf = *(const bf16x8*)(Kn + (size_t)(r0 + 16 * (nb0 + n2) + fr) * 512 + h * 128 + 32 * ks + 8 * fq);
                    S[n2] = __builtin_amdgcn_mfma_f32_16x16x32_bf16(kf, qf[ks], S[n2], 0, 0, 0); }
        }
        __syncthreads();
        const int t = 16 * mb + fr;
        float pf[2][4], pb[2][4]; float sf = 0.f, sb = 0.f;
        {
            const float rowf = L[ROWF + t], rowb = L[ROWB + t];
#pragma unroll
            for (int n2 = 0; n2 < 2; ++n2)
#pragma unroll
                for (int jj = 0; jj < 4; ++jj) { const int s = 16 * (nb0 + n2) + 4 * fq + jj; const float sv = S[n2][jj];
                    pf[n2][jj] = (s <= t) ? sv * __expf(rowf + L[COLF + s]) : 0.f; pb[n2][jj] = (s >= t) ? sv * __expf(rowb + L[COLB + s]) : 0.f;
                    sf += pf[n2][jj]; sb += pb[n2][jj]; }
            sf += __shfl_xor(sf, 16); sf += __shfl_xor(sf, 32); sb += __shfl_xor(sb, 16); sb += __shfl_xor(sb, 32);
            if (fq == 0) { atomicAdd((float*)&L[RSF + t], sf); atomicAdd((float*)&L[RSB + t], sb); }
        }
        __syncthreads();
        {
            const float denf = L[RSF + t] + L[SCF + t] * L[QNF + t], denb = L[RSB + t] + L[SCB + t] * L[QNB + t];
            const float rf = 1.0f / fmaxf(fabsf(denf), L[EMF + t]), rb = 1.0f / fmaxf(fabsf(denb), L[EMB + t]);
#pragma unroll
            for (int n2 = 0; n2 < 2; ++n2) { u32x2 w; w.x = cvt_pk_bf16(rf * pf[n2][0] + rb * pb[n2][0], rf * pf[n2][1] + rb * pb[n2][1]);
                w.y = cvt_pk_bf16(rf * pf[n2][2] + rb * pb[n2][2], rf * pf[n2][3] + rb * pb[n2][3]);
                *(LAS u32x2*)(Pp + t * 72 + 16 * (nb0 + n2) + 4 * fq) = w; }
            if ((wave & 1) == 0 && fq == 0) { L[CF + t] = rf * L[SCF + t]; L[CB + t] = rb * L[SCB + t]; }
        }
        __syncthreads();
        f32x4 acc[4][2];
#pragma unroll
        for (int a = 0; a < 4; ++a) { acc[a][0] = (f32x4){0.f, 0.f, 0.f, 0.f}; acc[a][1] = (f32x4){0.f, 0.f, 0.f, 0.f}; }
        const int vb = 32 * wave;
#pragma unroll
        for (int ks = 0; ks < 2; ++ks) {
            bf16x8 vf[2];
#pragma unroll
            for (int nv = 0; nv < 2; ++nv) vf[nv] = *(const bf16x8*)(VT + (size_t)(h * 256 + vb + 16 * nv + fr) * NTOK + r0 + 32 * ks + 8 * fq);
#pragma unroll
            for (int m2 = 0; m2 < 4; ++m2) { const bf16x8 pr = *(const LAS bf16x8*)(Pp + (16 * m2 + fr) * 72 + 32 * ks + 8 * fq);
                acc[m2][0] = __builtin_amdgcn_mfma_f32_16x16x32_bf16(vf[0], pr, acc[m2][0], 0, 0, 0); acc[m2][1] = __builtin_amdgcn_mfma_f32_16x16x32_bf16(vf[1], pr, acc[m2][1], 0, 0, 0); }
        }
#pragma unroll
        for (int dir = 0; dir < 2; ++dir) {
            const bf16_t* cs = CS + (size_t)(dir ? idxb : idxf) * 32768;
            float scl[4];
#pragma unroll
            for (int m2 = 0; m2 < 4; ++m2) scl[m2] = L[(dir ? CB : CF) + 16 * m2 + fr];
#pragma unroll
            for (int ks = 0; ks < 4; ++ks) {
                bf16x8 cf[2];
#pragma unroll
                for (int nv = 0; nv < 2; ++nv) cf[nv] = __builtin_nontemporal_load((const bf16x8*)(cs + (size_t)(vb + 16 * nv + fr) * 128 + 32 * ks + 8 * fq));
#pragma unroll
                for (int m2 = 0; m2 < 4; ++m2) { const bf16x8 qs = scale8u(*(const bf16x8*)(Q + (size_t)(r0 + 16 * m2 + fr) * 512 + h * 128 + 32 * ks + 8 * fq), scl[m2]);
                    acc[m2][0] = __builtin_amdgcn_mfma_f32_16x16x32_bf16(cf[0], qs, acc[m2][0], 0, 0, 0); acc[m2][1] = __builtin_amdgcn_mfma_f32_16x16x32_bf16(cf[1], qs, acc[m2][1], 0, 0, 0); }
            }
        }
#pragma unroll
        for (int m2 = 0; m2 < 4; ++m2) { float s2 = 0.f;
#pragma unroll
            for (int nv = 0; nv < 2; ++nv)
#pragma unroll
                for (int jj = 0; jj < 4; ++jj) s2 += acc[m2][nv][jj] * acc[m2][nv][jj];
            s2 += __shfl_xor(s2, 16); s2 += __shfl_xor(s2, 32);
            if (fq == 0) atomicAdd((float*)&L[SSQ + 16 * m2 + fr], s2); }
        __syncthreads();
        u32x2 sov[4][2]; f32x4 gv[2];
#pragma unroll
        for (int nv = 0; nv < 2; ++nv) { gv[nv] = *(const f32x4*)(ghead + h * 256 + vb + 16 * nv + 4 * fq);
#pragma unroll
            for (int m2 = 0; m2 < 4; ++m2) sov[m2][nv] = __builtin_nontemporal_load((const u32x2*)(SO + (size_t)(r0 + 16 * m2 + fr) * 1024 + h * 256 + vb + 16 * nv + 4 * fq)); }
#pragma unroll
        for (int m2 = 0; m2 < 4; ++m2) { const int tt = 16 * m2 + fr, r = r0 + tt; const float rn = rsqrtf(L[SSQ + tt] * (1.0f / 256.0f) + EPSN);
#pragma unroll
            for (int nv = 0; nv < 2; ++nv) { const int col = h * 256 + vb + 16 * nv + 4 * fq; const f32x4 g = gv[nv]; const u32x2 so = sov[m2][nv];
                const f32x4 a = acc[m2][nv]; u32x2 w; w.x = cvt_pk_bf16(a[0] * rn * g.x * bf_lo(so.x), a[1] * rn * g.y * bf_hi(so.x)); w.y = cvt_pk_bf16(a[2] * rn * g.z * bf_lo(so.y), a[3] * rn * g.w * bf_hi(so.y));
                *(u32x2*)(HM + (size_t)r * 1024 + col) = w; } }
    }
}

__device__ __forceinline__ void phase_out_prompt(const Params& p, LAS unsigned char* ldsb, int bid, int G) {
    int tid = threadIdx.x; asm volatile("" : "+v"(tid));
    const int wave = tid >> 6, lane = tid & 63, fr = lane & 15, fq = lane >> 4;
    LAS float* L = (LAS float*)ldsb;
    enum { COLF = 0, COLB = 256, ROWF = 512, EMF = 576, ROWB = 640, EMB = 704, RSF = 768, RSB = 832, SSQ = 896, SCR = 960 };
    LAS bf16_t* Pp = (LAS bf16_t*)(ldsb + 4096);
    const float* GATES = (const float*)(p.ws + OFF_GATES);
    const bf16_t* Q = (const bf16_t*)(p.ws + OFF_Q); const bf16_t* Kn = (const bf16_t*)(p.ws + OFF_KN); const bf16_t* VT = (const bf16_t*)(p.ws + OFF_VT);
    const bf16_t* SO = (const bf16_t*)(p.ws + OFF_SO); bf16_t* HM = (bf16_t*)(p.ws + OFF_HM);
    const float* ghead = p.in[15];
    for (int item = bid; item < 256; item += G) {
        const int b = item >> 4, h = (item >> 2) & 3, j = item & 3, rs = b * 256, r0 = rs + 64 * j;
        __syncthreads();
        float cfl = 0.f, cbl = 0.f, pml = 0.f, sml = 0.f, bfl = 0.f, bbl = 0.f;
        if (wave < 4) { const float* gp = GATES + (size_t)(rs + 64 * wave + lane) * 16;
            const float li0 = gp[h], li1 = gp[4 + h], lf0 = gp[8 + h], lf1 = gp[12 + h];
            bfl = prefix_sum64(lf0, lane); bbl = suffix_sum64(lf1, lane); cfl = li0 - bfl; cbl = li1 - bbl;
            pml = prefix_max64(cfl, lane); sml = suffix_max64(cbl, lane);
            if (lane == 63) { L[SCR + wave] = bfl; L[SCR + 8 + wave] = pml; }
            if (lane == 0) { L[SCR + 4 + wave] = bbl; L[SCR + 12 + wave] = sml; } }
        if (tid < 64) { L[RSF + tid] = 0.f; L[RSB + tid] = 0.f; L[SSQ + tid] = 0.f; }
        const int mb = wave >> 1, nb0 = 8 * (wave & 1);
        f32x4 S[8];
        { bf16x8 qf[4];
#pragma unroll
          for (int ks = 0; ks < 4; ++ks) qf[ks] = *(const bf16x8*)(Q + (size_t)(r0 + 16 * mb + fr) * 512 + h * 128 + 32 * ks + 8 * fq);
#pragma unroll
          for (int n8 = 0; n8 < 8; ++n8) { S[n8] = (f32x4){0.f, 0.f, 0.f, 0.f};
#pragma unroll
              for (int ks = 0; ks < 4; ++ks) { const bf16x8 kf = *(const bf16x8*)(Kn + (size_t)(rs + 16 * (nb0 + n8) + fr) * 512 + h * 128 + 32 * ks + 8 * fq);
                  S[n8] = __builtin_amdgcn_mfma_f32_16x16x32_bf16(kf, qf[ks], S[n8], 0, 0, 0); } } }
        __syncthreads();
        if (wave < 4) { float offF = 0.f, offB = 0.f, carF = -3.0e38f, carB = -3.0e38f, run = 0.f;
            for (int w2 = 0; w2 < wave; ++w2) { carF = fmaxf(carF, L[SCR + 8 + w2] - run); run += L[SCR + w2]; }
            offF = run; run = 0.f;
            for (int w2 = 3; w2 > wave; --w2) { carB = fmaxf(carB, L[SCR + 12 + w2] - run); run += L[SCR + 4 + w2]; }
            offB = run;
            const float mxf = fmaxf(0.f, fmaxf(pml - offF, carF)), mxb = fmaxf(0.f, fmaxf(sml - offB, carB));
            L[COLF + 64 * wave + lane] = cfl - offF; L[COLB + 64 * wave + lane] = cbl - offB;
            if (wave == j) { L[ROWF + lane] = -mxf; L[EMF + lane] = __expf(-((bfl + offF) + mxf)); L[ROWB + lane] = -mxb; L[EMB + lane] = __expf(-((bbl + offB) + mxb)); } }
        __syncthreads();
        const int tl = 16 * mb + fr, tg = 64 * j + tl;
        float pf[8][4], pb[8][4];
        { const float rowf = L[ROWF + tl], rowb = L[ROWB + tl]; float sf = 0.f, sb = 0.f;
#pragma unroll
          for (int n8 = 0; n8 < 8; ++n8)
#pragma unroll
              for (int jj = 0; jj < 4; ++jj) { const int s = 16 * (nb0 + n8) + 4 * fq + jj; const float sv = S[n8][jj];
                  pf[n8][jj] = (s <= tg) ? sv * __expf(rowf + L[COLF + s]) : 0.f; pb[n8][jj] = (s >= tg) ? sv * __expf(rowb + L[COLB + s]) : 0.f;
                  sf += pf[n8][jj]; sb += pb[n8][jj]; }
          sf += __shfl_xor(sf, 16); sf += __shfl_xor(sf, 32); sb += __shfl_xor(sb, 16); sb += __shfl_xor(sb, 32);
          if (fq == 0) { atomicAdd((float*)&L[RSF + tl], sf); atomicAdd((float*)&L[RSB + tl], sb); } }
        __syncthreads();
        { const float rf = 1.0f / fmaxf(fabsf(L[RSF + tl]), L[EMF + tl]), rb = 1.0f / fmaxf(fabsf(L[RSB + tl]), L[EMB + tl]);
#pragma unroll
          for (int n8 = 0; n8 < 8; ++n8) { u32x2 w; w.x = cvt_pk_bf16(rf * pf[n8][0] + rb * pb[n8][0], rf * pf[n8][1] + rb * pb[n8][1]);
              w.y = cvt_pk_bf16(rf * pf[n8][2] + rb * pb[n8][2], rf * pf[n8][3] + rb * pb[n8][3]);
              *(LAS u32x2*)(Pp + tl * 264 + 16 * (nb0 + n8) + 4 * fq) = w; } }
        __syncthreads();
        f32x4 acc[4][2];
#pragma unroll
        for (int a = 0; a < 4; ++a) { acc[a][0] = (f32x4){0.f, 0.f, 0.f, 0.f}; acc[a][1] = (f32x4){0.f, 0.f, 0.f, 0.f}; }
        const int vb = 32 * wave;
#pragma unroll
        for (int ks = 0; ks < 8; ++ks) {
            bf16x8 vf[2];
#pragma unroll
            for (int nv = 0; nv < 2; ++nv) vf[nv] = *(const bf16x8*)(VT + (size_t)(h * 256 + vb + 16 * nv + fr) * NTOK + rs + 32 * ks + 8 * fq);
#pragma unroll
            for (int m2 = 0; m2 < 4; ++m2) { const bf16x8 pr = *(const LAS bf16x8*)(Pp + (16 * m2 + fr) * 264 + 32 * ks + 8 * fq);
                acc[m2][0] = __builtin_amdgcn_mfma_f32_16x16x32_bf16(vf[0], pr, acc[m2][0], 0, 0, 0); acc[m2][1] = __builtin_amdgcn_mfma_f32_16x16x32_bf16(vf[1], pr, acc[m2][1], 0, 0, 0); }
        }
#pragma unroll
        for (int m2 = 0; m2 < 4; ++m2) { float s2 = 0.f;
#pragma unroll
            for (int nv = 0; nv < 2; ++nv)
#pragma unroll
                for (int jj = 0; jj < 4; ++jj) s2 += acc[m2][nv][jj] * acc[m2][nv][jj];
            s2 += __shfl_xor(s2, 16); s2 += __shfl_xor(s2, 32);
            if (fq == 0) atomicAdd((float*)&L[SSQ + 16 * m2 + fr], s2); }
        u32x2 sov[4][2]; f32x4 gv[2];
#pragma unroll
        for (int nv = 0; nv < 2; ++nv) { gv[nv] = *(const f32x4*)(ghead + h * 256 + vb + 16 * nv + 4 * fq);
#pragma unroll
            for (int m2 = 0; m2 < 4; ++m2) sov[m2][nv] = __builtin_nontemporal_load((const u32x2*)(SO + (size_t)(r0 + 16 * m2 + fr) * 1024 + h * 256 + vb + 16 * nv + 4 * fq)); }
        __syncthreads();
#pragma unroll
        for (int m2 = 0; m2 < 4; ++m2) { const int tt = 16 * m2 + fr, r = r0 + tt; const float rn = rsqrtf(L[SSQ + tt] * (1.0f / 256.0f) + EPSN);
#pragma unroll
            for (int nv = 0; nv < 2; ++nv) { const int col = h * 256 + vb + 16 * nv + 4 * fq; const f32x4 g = gv[nv]; const u32x2 so = sov[m2][nv];
                const f32x4 a = acc[m2][nv]; u32x2 w; w.x = cvt_pk_bf16(a[0] * rn * g.x * bf_lo(so.x), a[1] * rn * g.y * bf_hi(so.x)); w.y = cvt_pk_bf16(a[2] * rn * g.z * bf_lo(so.y), a[3] * rn * g.w * bf_hi(so.y));
                *(u32x2*)(HM + (size_t)r * 1024 + col) = w; } }
    }
}

__device__ __forceinline__ void phase_norm2(const Params& p, int bid, int G) {
    const int wave = threadIdx.x >> 6, lane = threadIdx.x & 63;
    const float* MOD = (const float*)(p.ws + OFF_MOD); const bf16_t* Y = (const bf16_t*)(p.ws + OFF_T); const bf16_t* Y1 = (const bf16_t*)(p.ws + OFF_T + 16 * MiB); float* X1 = (float*)(p.ws + OFF_X1); bf16_t* H2 = (bf16_t*)(p.ws + OFF_H1);
    const float* gpost = p.in[10]; const float* gpre = p.in[11];
    for (int row = 2 * (bid * 8 + wave); row < NTOK; row += 2 * G * 8) {
        const float* x = row < NPROMPT ? p.in[0] + (size_t)row * 1024 : p.in[1] + (size_t)(row - NPROMPT) * 1024;
        const int ci = row < NPROMPT ? 0 : 1 + ((row - NPROMPT) >> 11);
        const float* md = MOD + ci * 6144;
        f32x4 yv[2][4], xi[2][4], gp[4], gt[4], gq[4], sh[4], sc[4];
#pragma unroll
        for (int j = 0; j < 4; ++j) { const int o = 256 * j + 4 * lane;
            gp[j] = *(const f32x4*)(gpost + o); gt[j] = *(const f32x4*)(md + 2048 + o); gq[j] = *(const f32x4*)(gpre + o); sh[j] = *(const f32x4*)(md + 3072 + o); sc[j] = *(const f32x4*)(md + 4096 + o);
#pragma unroll
            for (int q = 0; q < 2; ++q) { const size_t ro = (size_t)(row + q) * 1024 + o;
                const u32x2 a = __builtin_nontemporal_load((const u32x2*)(Y + ro)), b = __builtin_nontemporal_load((const u32x2*)(Y1 + ro)); yv[q][j] = (f32x4){bf_lo(a.x) + bf_lo(b.x), bf_hi(a.x) + bf_hi(b.x), bf_lo(a.y) + bf_lo(b.y), bf_hi(a.y) + bf_hi(b.y)};
                xi[q][j] = __builtin_nontemporal_load((const f32x4*)(x + q * 1024 + o)); } }
#pragma unroll
        for (int q = 0; q < 2; ++q) {
            float ss = 0.f;
#pragma unroll
            for (int j = 0; j < 4; ++j) ss += yv[q][j].x * yv[q][j].x + yv[q][j].y * yv[q][j].y + yv[q][j].z * yv[q][j].z + yv[q][j].w * yv[q][j].w;
            ss = wave_sum(ss); const float rstd = rsqrtf(ss * (1.0f / 1024.0f) + EPSN);
            f32x4 xv[4]; float s2 = 0.f;
#pragma unroll
            for (int j = 0; j < 4; ++j) { xv[j] = xi[q][j] + gt[j] * ((yv[q][j] * rstd) * gp[j]); s2 += xv[j].x * xv[j].x + xv[j].y * xv[j].y + xv[j].z * xv[j].z + xv[j].w * xv[j].w; }
            s2 = wave_sum(s2); const float rstd2 = rsqrtf(s2 * (1.0f / 1024.0f) + EPSN);
#pragma unroll
            for (int j = 0; j < 4; ++j) { const int o = 256 * j + 4 * lane;
                *(f32x4*)(X1 + (size_t)(row + q) * 1024 + o) = xv[j];
                const f32x4 hv = (xv[j] * rstd2) * gq[j] * (sc[j] + 1.0f) + sh[j];
                u32x2 w; w.x = cvt_pk_bf16(hv.x, hv.y); w.y = cvt_pk_bf16(hv.z, hv.w); *(u32x2*)(H2 + (size_t)(row + q) * 1024 + o) = w; }
        }
    }
}
__device__ __forceinline__ void phase_final(const Params& p, int bid, int G) {
    const int wave = threadIdx.x >> 6, lane = threadIdx.x & 63;
    const float* MOD = (const float*)(p.ws + OFF_MOD); const bf16_t* F = (const bf16_t*)(p.ws + OFF_T); const bf16_t* F1 = (const bf16_t*)(p.ws + OFF_T + 16 * MiB); const float* X1 = (const float*)(p.ws + OFF_X1);
    const float* gpost = p.in[12];
    const int stride = G * 8;
    for (int row0 = bid * 8 + wave; row0 < NTOK; row0 += 2 * stride) {
        const int rows[2] = {row0, (row0 + stride < NTOK) ? row0 + stride : row0};
        f32x4 yv[2][4], xi[2][4]; float ss[2] = {0.f, 0.f};
#pragma unroll
        for (int q = 0; q < 2; ++q)
#pragma unroll
            for (int j = 0; j < 4; ++j) { const size_t o = (size_t)rows[q] * 1024 + 256 * j + 4 * lane; { const u32x2 a = __builtin_nontemporal_load((const u32x2*)(F + o)), b = __builtin_nontemporal_load((const u32x2*)(F1 + o)); yv[q][j] = (f32x4){bf_lo(a.x) + bf_lo(b.x), bf_hi(a.x) + bf_hi(b.x), bf_lo(a.y) + bf_lo(b.y), bf_hi(a.y) + bf_hi(b.y)}; } xi[q][j] = __builtin_nontemporal_load((const f32x4*)(X1 + o));
                ss[q] += yv[q][j].x * yv[q][j].x + yv[q][j].y * yv[q][j].y + yv[q][j].z * yv[q][j].z + yv[q][j].w * yv[q][j].w; }
#pragma unroll
        for (int q = 0; q < 2; ++q) {
            if (q == 1 && rows[1] == rows[0]) break;
            const int row = rows[q]; const int ci = row < NPROMPT ? 0 : 1 + ((row - NPROMPT) >> 11); const float* md = MOD + ci * 6144;
            const float rstd = rsqrtf(wave_sum(ss[q]) * (1.0f / 1024.0f) + EPSN);
#pragma unroll
            for (int j = 0; j < 4; ++j) { const int o = 256 * j + 4 * lane; const f32x4 g = *(const f32x4*)(gpost + o), gt = *(const f32x4*)(md + 5120 + o);
                __builtin_nontemporal_store(xi[q][j] + gt * ((yv[q][j] * rstd) * g), (f32x4*)(p.out + (size_t)row * 1024 + o)); }
        }
    }
}
__device__ __forceinline__ void phase_conv(const Params& p, int bid, int G) {
    const bf16_t* UP = (const bf16_t*)(p.ws + OFF_UP); bf16_t* ACT = (bf16_t*)(p.ws + OFF_ACT);
    const float* cw = p.in[22]; const float* cb = p.in[23];
    const int T = G * 512;
    for (int q = bid * 512 + threadIdx.x; q < NTOK * (DFF / 8); q += T) {
        const int r = q / (DFF / 8), f0 = (q % (DFF / 8)) * 8;
        int t, cols; if (r < NPROMPT) { t = r & 255; cols = 256; } else { t = (r - NPROMPT) & 63; cols = 64; }
        float cv[2][8];
#pragma unroll
        for (int half = 0; half < 2; ++half) {
            const int col = half * DFF + f0;
            const f32x4 b0 = *(const f32x4*)(cb + col), b1 = *(const f32x4*)(cb + col + 4);
            float a[8] = {b0.x, b0.y, b0.z, b0.w, b1.x, b1.y, b1.z, b1.w};
#pragma unroll
            for (int k = 0; k < 3; ++k) { const int tt = t + k - 1; if (tt < 0 || tt >= cols) continue;
                const u32x4 w = *(const u32x4*)(UP + (size_t)(r + k - 1) * NUP + col);
                const f32x4 c0 = *(const f32x4*)(cw + k * NUP + col), c1 = *(const f32x4*)(cw + k * NUP + col + 4);
                a[0] += bf_lo(w.x) * c0.x; a[1] += bf_hi(w.x) * c0.y; a[2] += bf_lo(w.y) * c0.z; a[3] += bf_hi(w.y) * c0.w;
                a[4] += bf_lo(w.z) * c1.x; a[5] += bf_hi(w.z) * c1.y; a[6] += bf_lo(w.w) * c1.z; a[7] += bf_hi(w.w) * c1.w; }
#pragma unroll
            for (int e = 0; e < 8; ++e) cv[half][e] = a[e];
        }
        float o[8];
#pragma unroll
        for (int e = 0; e < 8; ++e) { const float x = cv[0][e]; const float gl = x * __builtin_amdgcn_rcpf(1.0f + __expf(-1.5957691216057308f * (x + 0.044715f * x * x * x))); o[e] = gl * cv[1][e]; }
        u32x4 w; w.x = cvt_pk_bf16(o[0], o[1]); w.y = cvt_pk_bf16(o[2], o[3]); w.z = cvt_pk_bf16(o[4], o[5]); w.w = cvt_pk_bf16(o[6], o[7]);
        *(u32x4*)(ACT + (size_t)r * DFF + f0) = w;
    }
}

#define XB_TMO      128
#define XB_XCNT(j)  (256  + 64 * (j))
#define XB_XSUB(j)  (1280 + 64 * (j))
#define XB_XGEN(j)  (2304 + 64 * (j))
#define XB_TOP      3328
#define XB_TOPGEN   3392
#define XCD_BAR_WORDS 3456
#define XB_SPIN_CAP (1u << 18)
__device__ __forceinline__ unsigned xb_ld(unsigned* p)              { return __hip_atomic_load(p, __ATOMIC_RELAXED, __HIP_MEMORY_SCOPE_AGENT); }
__device__ __forceinline__ unsigned xb_add(unsigned* p, unsigned v) { return __hip_atomic_fetch_add(p, v, __ATOMIC_RELAXED, __HIP_MEMORY_SCOPE_AGENT); }
__device__ __forceinline__ unsigned xb_xcc_id() { return (unsigned)__builtin_amdgcn_s_getreg((3 << 11) | 20) & 0xFu; }
#define XB_SPIN(cond, bar) do { unsigned _sp = 0; while (cond) { __builtin_amdgcn_s_sleep(1); \
    if ((++_sp & 255u) == 0u) { if (xb_ld(&(bar)[XB_TMO])) break; if (_sp > XB_SPIN_CAP) { atomicAdd(&(bar)[XB_TMO], 1u); break; } } } } while (0)
struct XcdBarrier { unsigned* bar; unsigned x; volatile LAS unsigned* st; };
__device__ __forceinline__ XcdBarrier xcd_barrier_post(unsigned* bar, volatile LAS unsigned* st) {
    XcdBarrier b; b.bar = bar; b.x = xb_xcc_id(); b.st = st;
    if (threadIdx.x == 0) (void)xb_add(&bar[XB_XCNT(b.x)], 1u);
    return b;
}
__device__ __forceinline__ void xcd_barrier_complete(unsigned* bar, unsigned x, unsigned& nloc, unsigned& nx) {
    const unsigned G = gridDim.x * gridDim.y * gridDim.z;
    unsigned sum, cnt, mine, sp = 0u;
    for (;;) {
        sum = 0u; cnt = 0u; mine = 0u;
#pragma unroll
        for (unsigned j = 0; j < 16; ++j) { const unsigned c = xb_ld(&bar[XB_XCNT(j)]); sum += c; cnt += (c > 0u) ? 1u : 0u; mine = (j == x) ? c : mine; }
        if (sum == G) break;
        __builtin_amdgcn_s_sleep(1);
        if ((++sp & 255u) == 0u) { if (xb_ld(&bar[XB_TMO])) break; if (sp > XB_SPIN_CAP) { atomicAdd(&bar[XB_TMO], 1u); break; } }
    }
    nloc = mine > 0u ? mine : 1u; nx = cnt > 0u ? cnt : 1u;
}
__device__ __forceinline__ void xcd_barrier(const XcdBarrier& b) {
    asm volatile("s_waitcnt vmcnt(0)" ::: "memory");
    __syncthreads();
    if (threadIdx.x == 0) {
        unsigned* bar = b.bar;
        __builtin_amdgcn_s_waitcnt(0);
        unsigned nloc = b.st[0], nx = b.st[1];
        if (nloc == 0u) { xcd_barrier_complete(bar, b.x, nloc, nx); b.st[0] = nloc; b.st[1] = nx; }
        const unsigned old = xb_add(&bar[XB_XSUB(b.x)], 1u);
        const unsigned gen = old / nloc;
        if (old + 1u == (gen + 1u) * nloc) {
            __builtin_amdgcn_fence(__ATOMIC_RELEASE, "agent");
            asm volatile("s_waitcnt vmcnt(0)" ::: "memory");
            const unsigned og = xb_add(&bar[XB_TOP], 1u);
            const unsigned tg = og / nx;
            if (og + 1u == (tg + 1u) * nx) xb_add(&bar[XB_TOPGEN], 1u);
            else XB_SPIN(xb_ld(&bar[XB_TOPGEN]) == tg, bar);
            __builtin_amdgcn_fence(__ATOMIC_ACQUIRE, "agent");
            xb_add(&bar[XB_XGEN(b.x)], 1u);
            asm volatile("s_waitcnt vmcnt(0)" ::: "memory");
        } else {
            XB_SPIN(xb_ld(&bar[XB_XGEN(b.x)]) == gen, bar);
            __builtin_amdgcn_fence(__ATOMIC_ACQUIRE, "agent");
            asm volatile("s_waitcnt vmcnt(0)" ::: "memory");
        }
    }
    __syncthreads();
}
constexpr size_t OFF_BAR = OFF_SMALL + 1280 * 1024;
constexpr int LDS_BYTES = 131072 + 256 + 8192;
#define GRID_SYNC() xcd_barrier(xb)

typedef const __attribute__((address_space(4))) Params* KParams;
#define PH_PARAMS() KParams q_ = (KParams)__builtin_amdgcn_kernarg_segment_ptr(); asm volatile("" : "+s"(q_)); Params p; _Pragma("unroll") for (int i_ = 0; i_ < 25; ++i_) p.in[i_] = q_->in[i_]; p.out = q_->out; p.ws = q_->ws; unsigned char* ws = p.ws; (void)ws
__global__ __launch_bounds__(512, 2) void mk_fwd(Params p_arg) {
    extern __shared__ __attribute__((aligned(16))) unsigned char shm[];
    LAS unsigned char* lds = (LAS unsigned char*)shm;
    cg::grid_group grid = cg::this_grid();
    const int bid = blockIdx.x, G = gridDim.x;
    pg8::StaticOrder S;
    volatile LAS unsigned* xst = (volatile LAS unsigned*)(lds + 131072);
    if (threadIdx.x == 0) { xst[0] = 0u; xst[1] = 0u; }
    __syncthreads();
    XcdBarrier xb; { PH_PARAMS(); xb = xcd_barrier_post((unsigned*)(ws + OFF_BAR), xst); }
    { PH_PARAMS();
    phase0(p, lds, bid, G);
    }
    __syncthreads();
    { PH_PARAMS(); if (p.ws == nullptr) grid.sync(); }
    { PH_PARAMS();
    phase_norm1(p, lds, bid, G);
    }
    GRID_SYNC();
    { PH_PARAMS();
    { pg8::Gemm g{(const bf16_t*)(ws + OFF_H1), (const bf16_t*)(ws + OFF_WT_IN), NTOK, NZ, 1024, 1024, (NZ) / 256}; S.init(NTOK, NZ, G, bid);
      EpiZ E{(bf16_t*)(ws + OFF_Q), (bf16_t*)(ws + OFF_KN), (bf16_t*)(ws + OFF_KT), (bf16_t*)(ws + OFF_VT), (bf16_t*)(ws + OFF_SO), (bf16_t*)(ws + OFF_U), (bf16_t*)(ws + OFF_SGA), (bf16_t*)(ws + OFF_SGB)};
      pg8::gemm_phase(lds, g, S, E); }
    }
    { PH_PARAMS();
      const int nfull = ((NTOK / 256) * (NZ / 256)) % G;
      if (nfull > 0 && bid >= nfull) tile_loop<2>(p, (LAS float*)lds, bid - nfull, G - nfull); else if (nfull == 0) tile_loop<2>(p, (LAS float*)lds, bid, G);
    }
    GRID_SYNC();
    { PH_PARAMS();
    phase_chunk(p, lds, bid, G);
    }
    if (G <= 128) { PH_PARAMS();
    phase_prompt_final(p, lds, bid, G);
    }
    GRID_SYNC();
    { PH_PARAMS();
    phase_scan(p, lds, bid, G);
    }
    GRID_SYNC();
    { PH_PARAMS();
    phase_out(p, lds, bid, G);
    }
    { PH_PARAMS();
    phase_out_prompt(p, lds, bid, G);
    }
    GRID_SYNC();
    if (G > 128 && bid >= 128) { PH_PARAMS();
    phase_prompt_final(p, lds, bid - 128, G - 128);
    }
    { PH_PARAMS();
    {{ pg8::Gemm g{(const bf16_t*)(ws + OFF_HM), (const bf16_t*)(ws + OFF_WT_BRA), NTOK, 1024, 1024, 1024, (1024) / 256}; S.init(NTOK, 1024, G, bid);
      EpiT1 E{(bf16_t*)(ws + OFF_T), (const bf16_t*)(ws + OFF_SGA)};
      pg8::gemm_phase(lds, g, S, E); }
    { pg8::Gemm g{(const bf16_t*)(ws + OFF_DP), (const bf16_t*)(ws + OFF_WT_EFF), NTOK, 1024, 512, 512, (1024) / 256}; S.init(NTOK, 1024, G, bid);
      EpiMix E{(const bf16_t*)(ws + OFF_T), (const bf16_t*)(ws + OFF_SGB), (bf16_t*)(ws + OFF_H1)};
      pg8::gemm_phase(lds, g, S, E); }}
    }
    GRID_SYNC();
    { PH_PARAMS();
    { pg8::Gemm g{(const bf16_t*)(ws + OFF_H1), (const bf16_t*)(ws + OFF_WT_OUT), NTOK, 1024, 512, 1024, 4}; S.init(NTOK, 2048, G, bid);
      EpiF32 E{(bf16_t*)(ws + OFF_T), (bf16_t*)(ws + OFF_T + 16 * MiB), 1024};
      pg8::gemm_phase(lds, g, S, E); }
    }
    GRID_SYNC();
    { PH_PARAMS();
    phase_norm2(p, bid, G);
    }
    GRID_SYNC();
    { PH_PARAMS();
    { pg8::Gemm g{(const bf16_t*)(ws + OFF_H1), (const bf16_t*)(ws + OFF_WT_UP), NTOK, NUP, 1024, 1024, (NUP) / 256}; S.init(NTOK, NUP, G, bid);
      EpiConv E{(bf16_t*)(ws + OFF_ACT), p.in[22], p.in[23], (LAS float*)(lds + 131072 + 256)};
      pg8::gemm_phase(lds, g, S, E); }
    }
    { PH_PARAMS();
      const int nfull = ((NTOK / 256) * (NUP / 256)) % G;
      if (nfull > 0 && bid >= nfull) tile_loop<1>(p, (LAS float*)lds, bid - nfull, G - nfull); else if (nfull == 0) tile_loop<1>(p, (LAS float*)lds, bid, G);
    }
    GRID_SYNC();
    { PH_PARAMS();
    { pg8::Gemm g{(const bf16_t*)(ws + OFF_ACT), (const bf16_t*)(ws + OFF_WT_DOWN), NTOK, 1024, DFF / 2, DFF, 4}; S.init(NTOK, 2048, G, bid);
      EpiF32 E{(bf16_t*)(ws + OFF_T), (bf16_t*)(ws + OFF_T + 16 * MiB), 1024};
      pg8::gemm_phase(lds, g, S, E); }
    }
    GRID_SYNC();
    { PH_PARAMS();
    phase_final(p, bid, G);
    }
}

extern "C" void kernel_launch(void* const* d_in, const int* in_sizes, int n_in, void* d_out, int out_size, void* d_ws, size_t ws_size, hipStream_t stream) {
    static int grid = 0;
    if (grid == 0) {
        if (n_in != 25 || ws_size < WS_NEED) { fprintf(stderr, "kernel_launch: unexpected inputs (n_in %d, ws %zu)\n", n_in, ws_size); grid = -1; return; }
        int dev = 0, cus = 0, per_cu = 0;
        if (hipGetDevice(&dev) != hipSuccess || hipDeviceGetAttribute(&cus, hipDeviceAttributeMultiprocessorCount, dev) != hipSuccess) { grid = -1; return; }
        if (hipFuncSetAttribute((const void*)mk_fwd, hipFuncAttributeMaxDynamicSharedMemorySize, LDS_BYTES) != hipSuccess) { fprintf(stderr, "kernel_launch: hipFuncSetAttribute failed\n"); grid = -1; return; }
        if (hipOccupancyMaxActiveBlocksPerMultiprocessor(&per_cu, (const void*)mk_fwd, 512, LDS_BYTES) != hipSuccess || per_cu < 1) { fprintf(stderr, "kernel_launch: occupancy query says %d blocks per CU\n", per_cu); (void)hipGetLastError(); per_cu = 1; }
        grid = cus;
    }
    if (grid < 0) return;
    if (hipMemsetAsync((char*)d_ws + OFF_BAR, 0, 16384 + 3 * 6144 * 4, stream) != hipSuccess) { fprintf(stderr, "kernel_launch: memset failed\n"); return; }
    Params p{};
    for (int i = 0; i < 25; ++i) p.in[i] = (const float*)d_in[i];
    p.out = (float*)d_out; p.ws = (unsigned char*)d_ws;
    void* args[] = {&p};
    hipError_t e = hipLaunchCooperativeKernel((const void*)mk_fwd, dim3(grid), dim3(512), args, LDS_BYTES, stream);
    if (e != hipSuccess) fprintf(stderr, "kernel_launch: cooperative launch failed: %s (grid %d)\n", hipGetErrorString(e), grid);
}
```

```cpp
#include <hip/hip_runtime.h>
#include <hip/hip_cooperative_groups.h>
#include <cstdio>
namespace cg = cooperative_groups;

#define LAS __attribute__((address_space(3)))
typedef unsigned short bf16_t;
typedef short bf16x8 __attribute__((ext_vector_type(8)));
typedef float f32x4 __attribute__((ext_vector_type(4)));
typedef float f32x2 __attribute__((ext_vector_type(2)));
typedef unsigned u32x4 __attribute__((ext_vector_type(4)));
typedef unsigned u32x2 __attribute__((ext_vector_type(2)));

constexpr int DM = 1024, NTOK = 8192, NPROMPT = 4096;
constexpr int INC = 5648, NZ = 5632, DFF = 2816, NUP = 5632;
constexpr float EPSN = 1e-6f;
constexpr size_t MiB = 1u << 20;
constexpr size_t OFF_WT_IN = 0, OFF_WT_UP = 11 * MiB, OFF_WT_DOWN = 22 * MiB, OFF_WT_BRA = 28 * MiB, OFF_WT_EFF = 30 * MiB, OFF_WT_OUT = 31 * MiB;
constexpr size_t OFF_SMALL = 33 * MiB;
constexpr size_t OFF_MODCNT = OFF_SMALL + 1280 * 1024 + 16128, OFF_MOD = OFF_SMALL + 1280 * 1024 + 16384, OFF_GATES = OFF_SMALL + 128 * 1024, OFF_NCH = OFF_SMALL + 640 * 1024, OFF_WMAX = OFF_SMALL + 1152 * 1024,
                 OFF_BLAST = OFF_SMALL + 1156 * 1024, OFF_MS = OFF_SMALL + 1160 * 1024;
constexpr size_t OFF_H1 = 35 * MiB, OFF_KV = 51 * MiB, OFF_T = 51 * MiB, OFF_X1 = 83 * MiB, OFF_SGA = 115 * MiB, OFF_SGB = 131 * MiB, OFF_DP = 147 * MiB,
                 OFF_HM = 155 * MiB, OFF_Q = 171 * MiB, OFF_KN = 179 * MiB, OFF_KT = 187 * MiB, OFF_VT = 195 * MiB, OFF_SO = 211 * MiB, OFF_U = 227 * MiB,
                 OFF_UP = 115 * MiB, OFF_ACT = 203 * MiB, WS_NEED = 247 * MiB;
constexpr int OUT_C = 8388608, OUT_N = 12582912, OUT_M = 12599296;

struct Params { const float* in[25]; float* out; unsigned char* ws; };

typedef __bf16 bf16v2 __attribute__((ext_vector_type(2)));
__device__ __forceinline__ unsigned cvt_pk_bf16(float lo, float hi) { f32x2 v = {lo, hi}; bf16v2 b = __builtin_convertvector(v, bf16v2); return __builtin_bit_cast(unsigned, b); }
__device__ __forceinline__ float bf_lo(unsigned u) { return __uint_as_float(u << 16); }
__device__ __forceinline__ float bf_hi(unsigned u) { return __uint_as_float(u & 0xffff0000u); }
__device__ __forceinline__ float bf2f(bf16_t b) { return __uint_as_float(((unsigned)b) << 16); }
__device__ __forceinline__ float sigmoidf_(float x) { return __builtin_amdgcn_rcpf(1.0f + __expf(-x)); }
__device__ __forceinline__ float wave_sum(float v) {
#pragma unroll
    for (int o = 1; o < 64; o <<= 1) v += __shfl_xor(v, o);
    return v;
}

namespace pg8 {
constexpr int BM = 256, BK = 64, HALF = 128, HTB = HALF * BK * 2, STAGE_BYTES = 8 * HTB, NXCD = 8, WGM = 8;
__host__ __device__ __forceinline__ int lds_byte(int r, int c) { const int st = (r >> 4) * 2 + (c >> 5), rr = r & 15, cc = c & 31, ob = rr * 64 + cc * 2; return st * 1024 + (ob ^ (((ob >> 9) & 1) << 5)); }
__host__ __device__ __forceinline__ void stage_rc(int b, int& R, int& C) { const int st = b / 1024, sb = b % 1024, swz = sb ^ (((sb >> 9) & 1) << 5); R = (st >> 1) * 16 + swz / 64; C = (st & 1) * 32 + (swz % 64) / 2; }
__host__ __device__ __forceinline__ int perm32(int rho) { const int n = rho >> 4, i = rho & 15; return 8 * (i >> 2) + 4 * n + (i & 3); }
struct Unit { int pm, pn; };
struct Gemm { const bf16_t* A; const bf16_t* Bt; int M, N, K; int ld; int nNr; };
struct StaticOrder {
    int nM, nN, nwg, G, c, rep;
    __device__ void init(int M, int N, int G_, int c_, int rep_ = 1) { nM = M / BM; nN = N / BM; nwg = nM * nN; G = G_; c = c_; rep = rep_; }
    __device__ bool next(int i, Unit& u) const {
        const long L = (long)(i / rep) * G + c; if (L >= nwg) return false;
        int wgid = (int)L; { const int q = nwg / NXCD, r = nwg % NXCD, xcd = wgid % NXCD, off = wgid / NXCD; wgid = (xcd < r ? xcd * (q + 1) : r * (q + 1) + (xcd - r) * q) + off; }
        const int nig = WGM * nN, gid = wgid / nig, fm = gid * WGM, gsz = (nM - fm) < WGM ? (nM - fm) : WGM;
        u.pm = fm + ((wgid % nig) % gsz); u.pn = (wgid % nig) / gsz; return true;
    }
};

template <class Epi>
__device__ __forceinline__ void gemm_phase(LAS unsigned char* lds, const Gemm g, const StaticOrder& S, const Epi& E) {
    int tid = threadIdx.x; asm volatile("" : "+v"(tid));
    const int wid = __builtin_amdgcn_readfirstlane(tid >> 6), lane = tid & 63, wr = wid >> 2, wc = wid & 3, fr = lane & 15, fq = lane >> 4;
    const int K = g.K, nt = K / BK;
    unsigned voffA[2], voffB[2];
#pragma unroll
    for (int i = 0; i < 2; ++i) { int R, C; stage_rc(tid * 16 + i * 8192, R, C); const int Rb = Epi::PERM ? ((R & ~31) + perm32(R & 31)) : R;
        voffA[i] = (unsigned)(R * g.ld + C) * 2u; voffB[i] = (unsigned)(Rb * g.ld + C) * 2u; }
    const size_t kstep = (size_t)(BK * 2);
    const size_t hstep = (size_t)HALF * g.ld * 2;
    const size_t tstep = 2 * hstep;
    const unsigned ldsw = (unsigned)wid * 1024u;
    const int aoff = lds_byte(wr * 64 + fr, fq * 8), boff = lds_byte(wc * 32 + fr, fq * 8);
#define PG8_SA(b, h) (((b) * 2 + (h)) * HTB)
#define PG8_SB(b, h) ((4 + (b) * 2 + (h)) * HTB)
#define PG8_STAGE(bufoff, gbase, voff) do { _Pragma("unroll") for (int _i = 0; _i < 2; ++_i) \
        __builtin_amdgcn_global_load_lds((const unsigned*)((const char*)(gbase) + (voff)[_i]), (LAS unsigned*)(lds + (bufoff) + ldsw + _i * 8192), 16, 0, 0); } while (0)
#define PG8_LDA(dst, b, h) do { _Pragma("unroll") for (int m = 0; m < 4; ++m) _Pragma("unroll") for (int k = 0; k < 2; ++k) dst[m][k] = *(const LAS bf16x8*)(lds + PG8_SA(b, h) + aoff + m * 2048 + k * 1024); } while (0)
#define PG8_LDB(dst, b, h) do { _Pragma("unroll") for (int n = 0; n < 2; ++n) _Pragma("unroll") for (int k = 0; k < 2; ++k) dst[n][k] = *(const LAS bf16x8*)(lds + PG8_SB(b, h) + boff + n * 2048 + k * 1024); } while (0)
#define PG8_MMA(ai, bj, At, Bt) do { __builtin_amdgcn_s_setprio(1); _Pragma("unroll") for (int m = 0; m < 4; ++m) _Pragma("unroll") for (int n = 0; n < 2; ++n) _Pragma("unroll") for (int k = 0; k < 2; ++k) \
        acc[ai][bj][m][n] = __builtin_amdgcn_mfma_f32_16x16x32_bf16(Bt[n][k], At[m][k], acc[ai][bj][m][n], 0, 0, 0); __builtin_amdgcn_s_setprio(0); } while (0)
#define PG8_WAIT_V(n) asm volatile("s_waitcnt vmcnt(" #n ")" ::: "memory")
#define PG8_WAIT_L(n) asm volatile("s_waitcnt lgkmcnt(" #n ")" ::: "memory")
#define PG8_BAR __builtin_amdgcn_s_barrier()
#define PG8_SCHED __builtin_amdgcn_sched_barrier(0)
    Unit cur, nxt; int ui = 0;
    if (!S.next(0, cur)) return;
    f32x4 acc[2][2][4][2];
#pragma unroll
    for (int a = 0; a < 2; ++a)
#pragma unroll
        for (int b = 0; b < 2; ++b)
#pragma unroll
            for (int m = 0; m < 4; ++m)
#pragma unroll
                for (int n = 0; n < 2; ++n) acc[a][b][m][n] = (f32x4){0.f, 0.f, 0.f, 0.f};
    bf16x8 At[4][2], B0[2][2], B1[2][2];
    const char* cA = (const char*)g.A + (size_t)cur.pm * tstep + (size_t)(cur.pn / g.nNr) * K * 2; const char* cB = (const char*)g.Bt + (size_t)(cur.pn % g.nNr) * tstep + (size_t)(cur.pn / g.nNr) * K * 2;
    PG8_STAGE(PG8_SB(0, 0), cB, voffB); PG8_STAGE(PG8_SA(0, 0), cA, voffA); PG8_STAGE(PG8_SB(0, 1), cB + hstep, voffB); PG8_STAGE(PG8_SA(0, 1), cA + hstep, voffA);
    if (wr == 1) PG8_BAR;
    PG8_WAIT_V(4); PG8_BAR;
    PG8_STAGE(PG8_SB(1, 0), cB + kstep, voffB); PG8_STAGE(PG8_SA(1, 0), cA + kstep, voffA); PG8_STAGE(PG8_SB(1, 1), cB + hstep + kstep, voffB);
    PG8_WAIT_V(6); PG8_BAR;
    for (;;) {
        const bool has_next = S.next(ui + 1, nxt);
        const char* nA = has_next ? (const char*)g.A + (size_t)nxt.pm * tstep + (size_t)(nxt.pn / g.nNr) * K * 2 : cA; const char* nB = has_next ? (const char*)g.Bt + (size_t)(nxt.pn % g.nNr) * tstep + (size_t)(nxt.pn / g.nNr) * K * 2 : cB;
        for (int t = 0; t < nt; t += 2) {
            const bool last = (t == nt - 2);
            const char* a1 = cA + (size_t)(t + 1) * kstep;
            const char* a2 = last ? nA : cA + (size_t)(t + 2) * kstep; const char* b2 = last ? nB : cB + (size_t)(t + 2) * kstep;
            const char* a3 = a2 + kstep; const char* b3 = b2 + kstep;
            PG8_LDB(B0, 0, 0); PG8_SCHED; PG8_LDA(At, 0, 0); PG8_STAGE(PG8_SA(1, 1), a1 + hstep, voffA);
            PG8_WAIT_L(8); PG8_BAR; PG8_WAIT_L(0); PG8_MMA(0, 0, At, B0); PG8_BAR; PG8_SCHED;
            PG8_LDB(B1, 0, 1); PG8_STAGE(PG8_SB(0, 0), b2, voffB);
            PG8_BAR; PG8_WAIT_L(0); PG8_MMA(0, 1, At, B1); PG8_BAR;
            PG8_LDA(At, 0, 1); PG8_STAGE(PG8_SA(0, 0), a2, voffA);
            PG8_BAR; PG8_WAIT_L(0); PG8_MMA(1, 0, At, B0); PG8_BAR; PG8_SCHED;
            PG8_STAGE(PG8_SB(0, 1), b2 + hstep, voffB);
            PG8_WAIT_V(6); PG8_BAR; PG8_MMA(1, 1, At, B1); PG8_BAR;
            PG8_LDB(B0, 1, 0); PG8_SCHED; PG8_LDA(At, 1, 0); PG8_STAGE(PG8_SA(0, 1), a2 + hstep, voffA);
            PG8_WAIT_L(8); PG8_BAR; PG8_WAIT_L(0); PG8_MMA(0, 0, At, B0); PG8_BAR; PG8_SCHED;
            PG8_LDB(B1, 1, 1); PG8_STAGE(PG8_SB(1, 0), b3, voffB);
            PG8_BAR; PG8_WAIT_L(0); PG8_MMA(0, 1, At, B1); PG8_BAR;
            PG8_LDA(At, 1, 1); PG8_STAGE(PG8_SA(1, 0), a3, voffA);
            PG8_BAR; PG8_WAIT_L(0); PG8_MMA(1, 0, At, B0); PG8_BAR; PG8_SCHED;
            PG8_STAGE(PG8_SB(1, 1), b3 + hstep, voffB);
            PG8_WAIT_V(6); PG8_BAR; PG8_MMA(1, 1, At, B1); PG8_BAR;
        }
        E(acc, cur, wr, wc, fr, fq);
        if (!has_next) break;
#pragma unroll
        for (int a = 0; a < 2; ++a)
#pragma unroll
            for (int b = 0; b < 2; ++b)
#pragma unroll
                for (int m = 0; m < 4; ++m)
#pragma unroll
                    for (int n = 0; n < 2; ++n) acc[a][b][m][n] = (f32x4){0.f, 0.f, 0.f, 0.f};
        cur = nxt; cA = nA; cB = nB; ++ui;
    }
    PG8_WAIT_V(0);
    if (wr == 0) PG8_BAR;
    PG8_BAR;
#undef PG8_SA
#undef PG8_SB
#undef PG8_STAGE
#undef PG8_LDA
#undef PG8_LDB
#undef PG8_MMA
#undef PG8_WAIT_V
#undef PG8_WAIT_L
#undef PG8_BAR
#undef PG8_SCHED
}
}
using pg8::Unit;
#define EPI_LOOP_BEGIN \
    const int row0 = u.pm * 256 + wr * 64 + fr, colt = u.pn * 256 + wc * 32 + 8 * fq; \
    _Pragma("unroll") for (int ai = 0; ai < 2; ++ai) _Pragma("unroll") for (int m = 0; m < 4; ++m) { const int row = row0 + ai * 128 + m * 16; \
    _Pragma("unroll") for (int bj = 0; bj < 2; ++bj) { const int col = colt + bj * 128; f32x4 v0 = acc[ai][bj][m][0], v1 = acc[ai][bj][m][1];
#define EPI_LOOP_END } }

__device__ __forceinline__ u32x4 pack8(f32x4 v0, f32x4 v1) { u32x4 w; w.x = cvt_pk_bf16(v0[0], v0[1]); w.y = cvt_pk_bf16(v0[2], v0[3]); w.z = cvt_pk_bf16(v1[0], v1[1]); w.w = cvt_pk_bf16(v1[2], v1[3]); return w; }
__device__ __forceinline__ void unpack8(u32x4 w, f32x4& v0, f32x4& v1) { v0 = (f32x4){bf_lo(w.x), bf_hi(w.x), bf_lo(w.y), bf_hi(w.y)}; v1 = (f32x4){bf_lo(w.z), bf_hi(w.z), bf_lo(w.w), bf_hi(w.w)}; }

struct EpiZ {
    static constexpr bool PERM = true;
    bf16_t *Q, *Kn, *KT, *VT, *SO, *U, *SGA, *SGB;
    __device__ __forceinline__ void operator()(const f32x4 (&acc)[2][2][4][2], const Unit& u, int wr, int wc, int fr, int fq) const {
        const int pn = u.pn;
        if (pn < 2) {
            EPI_LOOP_BEGIN
                v0 *= 0.08838834764831845f; v1 *= 0.08838834764831845f;
                *(u32x4*)(Q + (size_t)row * 512 + col) = pack8(v0, v1);
            EPI_LOOP_END
        } else if (pn < 4) {
            EPI_LOOP_BEGIN
                const int c = col - 512;
                u32x4 w = pack8(v0, v1);
                *(u32x4*)(Kn + (size_t)row * 512 + c) = w;
                bf16_t* tp = KT + (size_t)c * NTOK + row;
                tp[0] = (bf16_t)(w.x & 0xffffu); tp[NTOK] = (bf16_t)(w.x >> 16); tp[2 * NTOK] = (bf16_t)(w.y & 0xffffu); tp[3 * NTOK] = (bf16_t)(w.y >> 16);
                tp[4 * NTOK] = (bf16_t)(w.z & 0xffffu); tp[5 * NTOK] = (bf16_t)(w.z >> 16); tp[6 * NTOK] = (bf16_t)(w.w & 0xffffu); tp[7 * NTOK] = (bf16_t)(w.w >> 16);
            EPI_LOOP_END
        } else if (pn < 8) {
            EPI_LOOP_BEGIN
                const int c = col - 1024;
                u32x4 w = pack8(v0, v1);
                bf16_t* tp = VT + (size_t)c * NTOK + row;
                tp[0] = (bf16_t)(w.x & 0xffffu); tp[NTOK] = (bf16_t)(w.x >> 16); tp[2 * NTOK] = (bf16_t)(w.y & 0xffffu); tp[3 * NTOK] = (bf16_t)(w.y >> 16);
                tp[4 * NTOK] = (bf16_t)(w.z & 0xffffu); tp[5 * NTOK] = (bf16_t)(w.z >> 16); tp[6 * NTOK] = (bf16_t)(w.w & 0xffffu); tp[7 * NTOK] = (bf16_t)(w.w >> 16);
            EPI_LOOP_END
        } else if (pn < 12) {
            EPI_LOOP_BEGIN
#pragma unroll
                for (int j = 0; j < 4; ++j) { v0[j] = sigmoidf_(v0[j]); v1[j] = sigmoidf_(v1[j]); }
                *(u32x4*)(SO + (size_t)row * 1024 + (col - 2048)) = pack8(v0, v1);
            EPI_LOOP_END
        } else if (pn < 14) {
            EPI_LOOP_BEGIN
                *(u32x4*)(U + (size_t)row * 512 + (col - 3072)) = pack8(v0, v1);
            EPI_LOOP_END
        } else if (pn < 18) {
            EPI_LOOP_BEGIN
#pragma unroll
                for (int j = 0; j < 4; ++j) { v0[j] = sigmoidf_(v0[j]); v1[j] = sigmoidf_(v1[j]); }
                *(u32x4*)(SGA + (size_t)row * 1024 + (col - 3584)) = pack8(v0, v1);
            EPI_LOOP_END
        } else {
            EPI_LOOP_BEGIN
#pragma unroll
                for (int j = 0; j < 4; ++j) { v0[j] = sigmoidf_(v0[j]); v1[j] = sigmoidf_(v1[j]); }
                *(u32x4*)(SGB + (size_t)row * 1024 + (col - 4608)) = pack8(v0, v1);
            EPI_LOOP_END
        }
    }
};
struct EpiT1 {
    static constexpr bool PERM = true;
    bf16_t* T; const bf16_t* SG;
    __device__ __forceinline__ void operator()(const f32x4 (&acc)[2][2][4][2], const Unit& u, int wr, int wc, int fr, int fq) const {
        const int row0 = u.pm * 256 + wr * 64 + fr, colt = u.pn * 256 + wc * 32 + 8 * fq;
#pragma unroll
        for (int ai = 0; ai < 2; ++ai) {
            u32x4 sg[4][2];
#pragma unroll
            for (int m = 0; m < 4; ++m)
#pragma unroll
                for (int bj = 0; bj < 2; ++bj) sg[m][bj] = *(const u32x4*)(SG + (size_t)(row0 + ai * 128 + m * 16) * 1024 + colt + bj * 128);
#pragma unroll
            for (int m = 0; m < 4; ++m)
#pragma unroll
                for (int bj = 0; bj < 2; ++bj) { f32x4 g0, g1; unpack8(sg[m][bj], g0, g1);
                    *(u32x4*)(T + (size_t)(row0 + ai * 128 + m * 16) * 1024 + colt + bj * 128) = pack8(acc[ai][bj][m][0] * g0, acc[ai][bj][m][1] * g1); }
        }
    }
};
struct EpiMix {
    static constexpr bool PERM = true;
    const bf16_t* T; const bf16_t* SG; bf16_t* O;
    __device__ __forceinline__ void operator()(const f32x4 (&acc)[2][2][4][2], const Unit& u, int wr, int wc, int fr, int fq) const {
        const int row0 = u.pm * 256 + wr * 64 + fr, colt = u.pn * 256 + wc * 32 + 8 * fq;
#pragma unroll
        for (int ai = 0; ai < 2; ++ai)
#pragma unroll
            for (int mh = 0; mh < 2; ++mh) {
                u32x4 sg[2][2], tt[2][2];
#pragma unroll
                for (int mm = 0; mm < 2; ++mm)
#pragma unroll
                    for (int bj = 0; bj < 2; ++bj) { const size_t o = (size_t)(row0 + ai * 128 + (2 * mh + mm) * 16) * 1024 + colt + bj * 128;
                        sg[mm][bj] = *(const u32x4*)(SG + o); tt[mm][bj] = *(const u32x4*)(T + o); }
#pragma unroll
                for (int mm = 0; mm < 2; ++mm)
#pragma unroll
                    for (int bj = 0; bj < 2; ++bj) { const int m = 2 * mh + mm; f32x4 g0, g1, t0, t1; unpack8(sg[mm][bj], g0, g1); unpack8(tt[mm][bj], t0, t1);
                        *(u32x4*)(O + (size_t)(row0 + ai * 128 + m * 16) * 1024 + colt + bj * 128) = pack8(t0 + acc[ai][bj][m][0] * g0, t1 + acc[ai][bj][m][1] * g1); }
            }
    }
};
struct EpiF32 {
    static constexpr bool PERM = true;
    bf16_t* C0; bf16_t* C1; int ldc;
    __device__ __forceinline__ void operator()(const f32x4 (&acc)[2][2][4][2], const Unit& u, int wr, int wc, int fr, int fq) const {
        bf16_t* C = (u.pn >= 4) ? C1 : C0;
        EPI_LOOP_BEGIN
            *(u32x4*)(C + (size_t)row * ldc + (col & 1023)) = pack8(v0, v1);
        EPI_LOOP_END
    }
};
struct EpiBf16 {
    static constexpr bool PERM = true;
    bf16_t* O; int ldc;
    __device__ __forceinline__ void operator()(const f32x4 (&acc)[2][2][4][2], const Unit& u, int wr, int wc, int fr, int fq) const {
        EPI_LOOP_BEGIN
            *(u32x4*)(O + (size_t)row * ldc + col) = pack8(v0, v1);
        EPI_LOOP_END
    }
};

__device__ __forceinline__ float dpp_ror1(float v) { return __builtin_bit_cast(float, __builtin_amdgcn_update_dpp(0, __builtin_bit_cast(int, v), 0x121, 0xf, 0xf, true)); }
__device__ __forceinline__ float dpp_ror15(float v) { return __builtin_bit_cast(float, __builtin_amdgcn_update_dpp(0, __builtin_bit_cast(int, v), 0x12f, 0xf, 0xf, true)); }
struct EpiConv {
    static constexpr bool PERM = true;
    bf16_t* ACT; const float* cw; const float* cb; LAS float* X;
    __device__ __forceinline__ void operator()(const f32x4 (&acc)[2][2][4][2], const Unit& u, int wr, int wc, int fr, int fq) const {
        const bool prompt = u.pm < 16;
        const int cl = wc * 32 + 8 * fq;
        if (prompt) {
#pragma unroll
            for (int ai = 0; ai < 2; ++ai)
#pragma unroll
                for (int bj = 0; bj < 2; ++bj) { const int b = 2 * ai + wr;
                    if (fr == 0) { *(LAS f32x4*)(X + ((b * 2 + 0) * 2 + bj) * 128 + cl) = acc[ai][bj][0][0]; *(LAS f32x4*)(X + ((b * 2 + 0) * 2 + bj) * 128 + cl + 4) = acc[ai][bj][0][1]; }
                    if (fr == 15) { *(LAS f32x4*)(X + ((b * 2 + 1) * 2 + bj) * 128 + cl) = acc[ai][bj][3][0]; *(LAS f32x4*)(X + ((b * 2 + 1) * 2 + bj) * 128 + cl + 4) = acc[ai][bj][3][1]; } }
            asm volatile("s_waitcnt lgkmcnt(0)" ::: "memory");
            __builtin_amdgcn_s_barrier(); __builtin_amdgcn_s_barrier();
            asm volatile("" ::: "memory");
        }
        const int f0 = u.pn * 128 + cl;
#pragma unroll
        for (int n = 0; n < 2; ++n) {
            __builtin_amdgcn_sched_barrier(0);
            f32x4 W[2][4];
#pragma unroll
            for (int bj = 0; bj < 2; ++bj) { const int col = bj * DFF + f0 + 4 * n;
                W[bj][0] = *(const f32x4*)(cw + col); W[bj][1] = *(const f32x4*)(cw + NUP + col); W[bj][2] = *(const f32x4*)(cw + 2 * NUP + col); W[bj][3] = *(const f32x4*)(cb + col); }
#pragma unroll
            for (int ai = 0; ai < 2; ++ai) {
                const int b = 2 * ai + wr;
                const bool has_prev = prompt && b > 0, has_next = prompt && b < 3;
                f32x4 c[2][4];
#pragma unroll
                for (int bj = 0; bj < 2; ++bj) {
                    f32x4 xp = {0.f, 0.f, 0.f, 0.f}, xn = {0.f, 0.f, 0.f, 0.f};
                    if (has_prev) xp = *(const LAS f32x4*)(X + (((b - 1) * 2 + 1) * 2 + bj) * 128 + cl + 4 * n);
                    if (has_next) xn = *(const LAS f32x4*)(X + (((b + 1) * 2 + 0) * 2 + bj) * 128 + cl + 4 * n);
#pragma unroll
                    for (int m = 0; m < 4; ++m) {
                        f32x4 pv, nv; const f32x4 x = acc[ai][bj][m][n];
#pragma unroll
                        for (int j = 0; j < 4; ++j) {
                            const float pin = dpp_ror1(x[j]), pseam = (m > 0) ? dpp_ror1(acc[ai][bj][m > 0 ? m - 1 : 0][n][j]) : xp[j];
                            const float nin = dpp_ror15(x[j]), nseam = (m < 3) ? dpp_ror15(acc[ai][bj][m < 3 ? m + 1 : 3][n][j]) : xn[j];
                            pv[j] = (fr == 0) ? pseam : pin; nv[j] = (fr == 15) ? nseam : nin;
                        }
                        c[bj][m] = W[bj][0] * pv + W[bj][1] * x + W[bj][2] * nv + W[bj][3];
                    }
                }
#pragma unroll
                for (int m = 0; m < 4; ++m) { float o[4];
#pragma unroll
                    for (int j = 0; j < 4; ++j) { const float x = c[0][m][j]; o[j] = x * __builtin_amdgcn_rcpf(1.0f + __builtin_amdgcn_exp2f(-2.302208198f * (x + 0.044715f * x * x * x))) * c[1][m][j]; }
                    u32x2 ow; ow.x = cvt_pk_bf16(o[0], o[1]); ow.y = cvt_pk_bf16(o[2], o[3]);
                    *(u32x2*)(ACT + (size_t)(u.pm * 256 + ai * 128 + wr * 64 + m * 16 + fr) * DFF + f0 + 4 * n) = ow; }
                __builtin_amdgcn_sched_barrier(0);
            }
        }
    }
};
__device__ __forceinline__ void transpose_item(const float* __restrict__ W, int ldw, int csrc, int K, bf16_t* WT, int rdst, int k0, LAS float* scr, int lane) {
    float tv[32];
#pragma unroll
    for (int i = 0; i < 32; ++i) { const int kk = 2 * i + (lane >> 5); tv[i] = W[(size_t)(k0 + kk) * ldw + csrc + (lane & 31)]; }
#pragma unroll
    for (int i = 0; i < 32; ++i) { const int kk = 2 * i + (lane >> 5); scr[kk * 33 + (lane & 31)] = tv[i]; }
    asm volatile("s_waitcnt lgkmcnt(0)" ::: "memory");
    const int c = lane & 7;
#pragma unroll
    for (int j = 0; j < 4; ++j) { const int n = (lane >> 3) + 8 * j; const LAS float* s = scr + (8 * c) * 33 + n;
        u32x4 o; o.x = cvt_pk_bf16(s[0], s[33]); o.y = cvt_pk_bf16(s[66], s[99]); o.z = cvt_pk_bf16(s[132], s[165]); o.w = cvt_pk_bf16(s[198], s[231]);
        *(u32x4*)(WT + (size_t)(rdst + n) * K + k0 + 8 * c) = o; }
    asm volatile("s_waitcnt lgkmcnt(0)" ::: "memory");
}

struct TileDesc { const float* W; bf16_t* WT; int ldw, c_lo, c_hi, K, rdst, k0; };
template <int SET> __device__ __forceinline__ TileDesc tile_desc(const Params& p, int it) {
    constexpr int T_IN = 16 * 22, T_UP = 16 * 22, T_DN = 44 * 4, T_A = 16 * 4, T_O = 16 * 4;
    TileDesc d; d.W = nullptr; d.WT = nullptr; d.ldw = d.c_lo = d.c_hi = d.K = d.rdst = d.k0 = 0;
    int r = it; if (r < 0) return d;
    if (SET == 0) {
        if (r < T_IN) { const int kb = r / 22, tl = r % 22, n0 = tl * 256, cs = n0 + (tl >= 12 ? 16 : 0); d = TileDesc{p.in[13], (bf16_t*)(p.ws + OFF_WT_IN), INC, cs, cs + 128, 1024, n0, kb * 64}; return d; } r -= T_IN;
        if (r < T_UP) { const int kb = r / 22, tl = r % 22; d = TileDesc{p.in[21], (bf16_t*)(p.ws + OFF_WT_UP), NUP, tl * 128, DFF + tl * 128, 1024, tl * 256, kb * 64}; return d; }
    } else if (SET == 1) {
        if (r < T_DN) { const int kb = r / 4, tl = r % 4; d = TileDesc{p.in[24], (bf16_t*)(p.ws + OFF_WT_DOWN), 1024, tl * 256, tl * 256 + 128, DFF, tl * 256, kb * 64}; return d; }
    } else {
        if (r < T_A) { const int kb = r / 4, tl = r % 4; d = TileDesc{p.in[18], (bf16_t*)(p.ws + OFF_WT_BRA), 1024, tl * 256, tl * 256 + 128, 1024, tl * 256, kb * 64}; return d; } r -= T_A;
        if (r < T_O) { const int kb = r / 4, tl = r % 4; d = TileDesc{p.in[20], (bf16_t*)(p.ws + OFF_WT_OUT), 1024, tl * 256, tl * 256 + 128, 1024, tl * 256, kb * 64}; return d; }
    }
    return d;
}
__device__ __forceinline__ void tile_load(const TileDesc& d, f32x4 (&v)[8], int tid) {
    const int wave = tid >> 6, lane = tid & 63;
    const int scol = (lane < 32) ? d.c_lo + 4 * lane : d.c_hi + 4 * (lane - 32);
#pragma unroll
    for (int i = 0; i < 8; ++i) v[i] = __builtin_nontemporal_load((const f32x4*)(d.W + (size_t)(d.k0 + wave * 8 + i) * d.ldw + scol));
}
__device__ __forceinline__ void tile_finish(const TileDesc& d, const f32x4 (&v)[8], LAS float* tile, int tid) {
    const int wave = tid >> 6, lane = tid & 63;
#pragma unroll
    for (int i = 0; i < 8; ++i) *(LAS f32x4*)(tile + (wave * 8 + i) * 260 + 4 * (lane ^ wave)) = v[i];
    __syncthreads();
    const int c = tid & 7;
#pragma unroll
    for (int j = 0; j < 4; ++j) { const int n = (tid >> 3) + 64 * j; const LAS float* s = tile + (8 * c) * 260 + 4 * ((n >> 2) ^ c) + (n & 3);
        u32x4 o; o.x = cvt_pk_bf16(s[0], s[260]); o.y = cvt_pk_bf16(s[520], s[780]); o.z = cvt_pk_bf16(s[1040], s[1300]); o.w = cvt_pk_bf16(s[1560], s[1820]);
        *(u32x4*)(d.WT + (size_t)(d.rdst + n) * d.K + d.k0 + 8 * c) = o; }
    __syncthreads();
}

template <int SET> __device__ __forceinline__ void tile_loop(const Params& p, LAS float* L, int first, int step) {
    int tid = threadIdx.x; asm volatile("" : "+v"(tid));
    TileDesc d0 = tile_desc<SET>(p, first), d1; f32x4 va[8], vb[8];
    if (d0.W) tile_load(d0, va, tid);
    for (int it = first; d0.W; it += 2 * step) {
        d1 = tile_desc<SET>(p, it + step); if (d1.W) tile_load(d1, vb, tid);
        tile_finish(d0, va, L, tid);
        if (!d1.W) break;
        d0 = tile_desc<SET>(p, it + 2 * step); if (d0.W) tile_load(d0, va, tid);
        tile_finish(d1, vb, L, tid);
    }
}

__device__ __forceinline__ void phase0(const Params& p, LAS unsigned char* ldsb, int bid, int G) {
    const int tid = threadIdx.x, wave = tid >> 6, lane = tid & 63;
    LAS float* L = (LAS float*)ldsb;
    {
        for (int i = tid; i < 3072; i += 512) { const int ci = i >> 10, d = i & 1023; const float c = (ci == 0) ? p.in[6][d] : p.in[5][(ci - 1) * 1024 + d]; L[i] = c / (1.0f + __expf(-c)); }
        __syncthreads();
        float* MODa = (float*)(p.ws + OFF_MOD);
        for (int wi = bid * 8 + wave; wi < 768; wi += G * 8) {
            const int cgp = wi % 24, dr = wi / 24, n0 = cgp * 256 + 4 * lane;
            const float* wa = p.in[7] + (size_t)(dr * 32) * 6144 + n0;
            f32x4 a0 = {0.f, 0.f, 0.f, 0.f}, a1 = a0, a2 = a0;
            if (dr == 0) { a0 = *(const f32x4*)(p.in[8] + n0); a1 = a0; a2 = a0; }
#pragma unroll 1
            for (int d0 = 0; d0 < 32; d0 += 16) {
                f32x4 w[16];
#pragma unroll
                for (int k = 0; k < 16; ++k) w[k] = __builtin_nontemporal_load((const f32x4*)(wa + (size_t)(d0 + k) * 6144));
#pragma unroll
                for (int k = 0; k < 16; ++k) { const int dd = dr * 32 + d0 + k; a0 += w[k] * L[dd]; a1 += w[k] * L[1024 + dd]; a2 += w[k] * L[2048 + dd]; }
            }
#pragma unroll
            for (int j = 0; j < 4; ++j) { atomicAdd(MODa + n0 + j, a0[j]); atomicAdd(MODa + 6144 + n0 + j, a1[j]); atomicAdd(MODa + 12288 + n0 + j, a2[j]); }
            asm volatile("s_waitcnt vmcnt(0)" ::: "memory");
            if (lane == 0) __hip_atomic_fetch_add((unsigned*)(p.ws + OFF_MODCNT), 1u, __ATOMIC_RELAXED, __HIP_MEMORY_SCOPE_AGENT);
        }
        __syncthreads();
    }
    for (int item = G - 1 - bid; item < 128; item += G) {
        const int gi = item >> 5, d0 = (item & 31) * 32;
        LAS float* Wp = L; LAS float* Wb = L + 128 * 129;
        const float* wp = p.in[16] + gi * 16384; const float* wb = p.in[19] + (size_t)(gi * 128) * 1024 + d0; const float* ps = p.in[17] + gi * 128;
        for (int i = tid; i < 16384; i += 512) { const int c = i >> 7, j = i & 127; Wp[c * 129 + j] = wp[i]; }
        for (int i = tid; i < 4096; i += 512) { const int j = i >> 5, dd = i & 31; Wb[i] = wb[(size_t)j * 1024 + dd] * ps[j]; }
        __syncthreads();
        const int c = tid & 127, dq = tid >> 7;
        float acc[8];
#pragma unroll
        for (int e = 0; e < 8; ++e) acc[e] = 0.f;
        for (int j = 0; j < 128; ++j) { const float a = Wp[c * 129 + j]; const f32x4 b0 = *(const LAS f32x4*)(Wb + j * 32 + dq * 8), b1 = *(const LAS f32x4*)(Wb + j * 32 + dq * 8 + 4);
            acc[0] += a * b0.x; acc[1] += a * b0.y; acc[2] += a * b0.z; acc[3] += a * b0.w; acc[4] += a * b1.x; acc[5] += a * b1.y; acc[6] += a * b1.z; acc[7] += a * b1.w; }
        bf16_t* we = (bf16_t*)(p.ws + OFF_WT_EFF);
#pragma unroll
        for (int e = 0; e < 8; ++e) we[(size_t)(d0 + dq * 8 + e) * 512 + gi * 128 + c] = (bf16_t)(cvt_pk_bf16(acc[e], 0.f) & 0xffffu);
        __syncthreads();
    }
    tile_loop<0>(p, L, bid, G);
}

__device__ __forceinline__ void phase_norm1(const Params& p, LAS unsigned char* ldsb, int bid, int G) {
    const int tid = threadIdx.x, wave = tid >> 6, lane = tid & 63;
    LAS float* Wg = (LAS float*)ldsb;
    const float* w_in = p.in[13];
    for (int i = tid; i < 4096; i += 512) { const int d = i >> 2, q = i & 3; const f32x4 v = *(const f32x4*)(w_in + (size_t)d * INC + 3072 + 4 * q);
        Wg[(4 * q + 0) * 1024 + d] = v.x; Wg[(4 * q + 1) * 1024 + d] = v.y; Wg[(4 * q + 2) * 1024 + d] = v.z; Wg[(4 * q + 3) * 1024 + d] = v.w; }
    if (tid == 0) {
        unsigned* cnt = (unsigned*)(p.ws + OFF_MODCNT); unsigned sp = 0;
        while (__hip_atomic_load(cnt, __ATOMIC_RELAXED, __HIP_MEMORY_SCOPE_AGENT) < 768u && ++sp < (1u << 22)) __builtin_amdgcn_s_sleep(2);
        __builtin_amdgcn_fence(__ATOMIC_ACQUIRE, "agent");
        asm volatile("s_waitcnt vmcnt(0)" ::: "memory");
    }
    __syncthreads();
    const float* MOD = (const float*)(p.ws + OFF_MOD); float* GATES = (float*)(p.ws + OFF_GATES); bf16_t* H1 = (bf16_t*)(p.ws + OFF_H1);
    const float* gpre = p.in[9]; const float* bg = p.in[14];
    for (int row0 = 2 * (bid * 8 + wave); row0 < NTOK; row0 += 2 * G * 8) {
        const float* x = row0 < NPROMPT ? p.in[0] + (size_t)row0 * 1024 : p.in[1] + (size_t)(row0 - NPROMPT) * 1024;
        const int ci = row0 < NPROMPT ? 0 : 1 + ((row0 - NPROMPT) >> 11);
        const float* md = MOD + ci * 6144;
        f32x4 xq[2][4], gv[4], shv[4], scv[4];
#pragma unroll
        for (int j = 0; j < 4; ++j) { const int o = 256 * j + 4 * lane; xq[0][j] = *(const f32x4*)(x + o); xq[1][j] = *(const f32x4*)(x + 1024 + o); gv[j] = *(const f32x4*)(gpre + o); shv[j] = *(const f32x4*)(md + o); scv[j] = *(const f32x4*)(md + 1024 + o); }
#pragma unroll
        for (int q = 0; q < 2; ++q) {
            const int row = row0 + q; float ss = 0.f;
#pragma unroll
            for (int j = 0; j < 4; ++j) ss += xq[q][j].x * xq[q][j].x + xq[q][j].y * xq[q][j].y + xq[q][j].z * xq[q][j].z + xq[q][j].w * xq[q][j].w;
            ss = wave_sum(ss); const float rstd = rsqrtf(ss * (1.0f / 1024.0f) + EPSN);
            f32x4 hv[4];
#pragma unroll
            for (int j = 0; j < 4; ++j) { const int o = 256 * j + 4 * lane;
                hv[j] = (xq[q][j] * rstd) * gv[j] * (scv[j] + 1.0f) + shv[j];
                u32x2 w; w.x = cvt_pk_bf16(hv[j].x, hv[j].y); w.y = cvt_pk_bf16(hv[j].z, hv[j].w); *(u32x2*)(H1 + (size_t)row * 1024 + o) = w; }
            float gvv[16];
#pragma unroll
            for (int g = 0; g < 16; ++g) { float a = 0.f;
                if ((g & 3) == 0) __builtin_amdgcn_sched_barrier(0);
#pragma unroll
                for (int j = 0; j < 4; ++j) { const f32x4 w = *(const LAS f32x4*)(Wg + g * 1024 + 256 * j + 4 * lane); a += hv[j].x * w.x + hv[j].y * w.y + hv[j].z * w.z + hv[j].w * w.w; }
                gvv[g] = a; }
            { const bool b0 = lane & 1, b1 = lane & 2, b2 = lane & 4, b3 = lane & 8;
#pragma unroll
              for (int i = 0; i < 8; ++i) { const float send = b0 ? gvv[i] : gvv[8 + i], keep = b0 ? gvv[8 + i] : gvv[i];
                  gvv[i] = keep + __builtin_bit_cast(float, __builtin_amdgcn_update_dpp(0, __builtin_bit_cast(int, send), 0xB1, 0xf, 0xf, true)); }
#pragma unroll
              for (int i = 0; i < 4; ++i) { const float send = b1 ? gvv[i] : gvv[4 + i], keep = b1 ? gvv[4 + i] : gvv[i];
                  gvv[i] = keep + __builtin_bit_cast(float, __builtin_amdgcn_update_dpp(0, __builtin_bit_cast(int, send), 0x4E, 0xf, 0xf, true)); }
#pragma unroll
              for (int i = 0; i < 2; ++i) { const float send = b2 ? gvv[i] : gvv[2 + i], keep = b2 ? gvv[2 + i] : gvv[i]; gvv[i] = keep + __shfl_xor(send, 4); }
              { const float send = b3 ? gvv[0] : gvv[1], keep = b3 ? gvv[1] : gvv[0]; gvv[0] = keep + __shfl_xor(send, 8); }
              gvv[0] += __shfl_xor(gvv[0], 16); gvv[0] += __shfl_xor(gvv[0], 32); }
            if (lane < 16) { const int g = ((lane & 1) << 3) | ((lane & 2) << 1) | ((lane & 4) >> 1) | ((lane & 8) >> 3);
                const float z = gvv[0] + bg[g]; const float o = g < 8 ? z : (fminf(z, 0.f) - log1pf(__expf(-fabsf(z)))); GATES[(size_t)row * 16 + g] = o; }
        }
    }
}

__device__ __forceinline__ bf16x8 scale8(bf16x8 v, const float (&s)[8]) {
    const u32x4 w = __builtin_bit_cast(u32x4, v); u32x4 o;
    o.x = cvt_pk_bf16(bf_lo(w.x) * s[0], bf_hi(w.x) * s[1]); o.y = cvt_pk_bf16(bf_lo(w.y) * s[2], bf_hi(w.y) * s[3]);
    o.z = cvt_pk_bf16(bf_lo(w.z) * s[4], bf_hi(w.z) * s[5]); o.w = cvt_pk_bf16(bf_lo(w.w) * s[6], bf_hi(w.w) * s[7]);
    return __builtin_bit_cast(bf16x8, o);
}
__device__ __forceinline__ bf16x8 scale8u(bf16x8 v, float s) {
    const u32x4 w = __builtin_bit_cast(u32x4, v); u32x4 o;
    o.x = cvt_pk_bf16(bf_lo(w.x) * s, bf_hi(w.x) * s); o.y = cvt_pk_bf16(bf_lo(w.y) * s, bf_hi(w.y) * s);
    o.z = cvt_pk_bf16(bf_lo(w.z) * s, bf_hi(w.z) * s); o.w = cvt_pk_bf16(bf_lo(w.w) * s, bf_hi(w.w) * s);
    return __builtin_bit_cast(bf16x8, o);
}
__device__ __forceinline__ float wave_max(float v) {
#pragma unroll
    for (int o = 1; o < 64; o <<= 1) v = fmaxf(v, __shfl_xor(v, o));
    return v;
}
#define DPP_OLD(oldv, v, ctrl, rmask) __builtin_bit_cast(float, __builtin_amdgcn_update_dpp(__builtin_bit_cast(int, (float)(oldv)), __builtin_bit_cast(int, (v)), (ctrl), (rmask), 0xf, false))
__device__ __forceinline__ float prefix_sum64(float v, int lane) {
    v += DPP_OLD(0.f, v, 0x111, 0xf); v += DPP_OLD(0.f, v, 0x112, 0xf); v += DPP_OLD(0.f, v, 0x114, 0xf); v += DPP_OLD(0.f, v, 0x118, 0xf);
    v += DPP_OLD(0.f, v, 0x142, 0xa);
    v += DPP_OLD(0.f, v, 0x143, 0xc);
    return v;
}
__device__ __forceinline__ float suffix_sum64(float v, int lane) {
#pragma unroll
    for (int o = 1; o < 64; o <<= 1) { const float t = __shfl_down(v, o); if (lane + o < 64) v += t; }
    return v;
}
__device__ __forceinline__ float prefix_max64(float v, int lane) {
    const float NI = -3.0e38f;
    v = fmaxf(v, DPP_OLD(NI, v, 0x111, 0xf)); v = fmaxf(v, DPP_OLD(NI, v, 0x112, 0xf)); v = fmaxf(v, DPP_OLD(NI, v, 0x114, 0xf)); v = fmaxf(v, DPP_OLD(NI, v, 0x118, 0xf));
    v = fmaxf(v, DPP_OLD(NI, v, 0x142, 0xa));
    v = fmaxf(v, DPP_OLD(NI, v, 0x143, 0xc));
    return v;
}
__device__ __forceinline__ float suffix_max64(float v, int lane) {
#pragma unroll
    for (int o = 1; o < 64; o <<= 1) { const float t = __shfl_down(v, o); if (lane + o < 64) v = fmaxf(v, t); }
    return v;
}

template <int HALFW> __device__ __forceinline__ void pool_task(const bf16_t* U, bf16_t* DP, int r, int t, int cols, int base, int ch0) {
    u32x4 w[2 * HALFW];
#pragma unroll
    for (int k = 0; k < 2 * HALFW; ++k) { const int tt = t - HALFW + k, tc = min(max(tt, 0), cols - 1); w[k] = *(const u32x4*)(U + (size_t)(base + tc) * 512 + ch0); }
    float s[8];
#pragma unroll
    for (int e = 0; e < 8; ++e) s[e] = 0.f;
#pragma unroll
    for (int k = 0; k < 2 * HALFW; ++k) { const int tt = t - HALFW + k; const float m = (tt >= 0 && tt < cols) ? 1.0f : 0.0f;
        s[0] += m * bf_lo(w[k].x); s[1] += m * bf_hi(w[k].x); s[2] += m * bf_lo(w[k].y); s[3] += m * bf_hi(w[k].y); s[4] += m * bf_lo(w[k].z); s[5] += m * bf_hi(w[k].z); s[6] += m * bf_lo(w[k].w); s[7] += m * bf_hi(w[k].w); }
    const int lo = max(t - HALFW, 0), hi = min(t + HALFW, cols);
    const float inv = 1.0f / (float)(hi - lo);
    const u32x4 c = w[HALFW]; u32x4 o;
    o.x = cvt_pk_bf16(s[0] * inv - bf_lo(c.x), s[1] * inv - bf_hi(c.x)); o.y = cvt_pk_bf16(s[2] * inv - bf_lo(c.y), s[3] * inv - bf_hi(c.y));
    o.z = cvt_pk_bf16(s[4] * inv - bf_lo(c.z), s[5] * inv - bf_hi(c.z)); o.w = cvt_pk_bf16(s[6] * inv - bf_lo(c.w), s[7] * inv - bf_hi(c.w));
    *(u32x4*)(DP + (size_t)r * 512 + ch0) = o;
}

__device__ __forceinline__ void phase_chunk(const Params& p, LAS unsigned char* ldsb, int bid, int G) {
    const int tid = threadIdx.x, wave = tid >> 6, lane = tid & 63, fr = lane & 15, fq = lane >> 4;
    LAS float* ew = (LAS float*)ldsb;
    const float* GATES = (const float*)(p.ws + OFF_GATES);
    const bf16_t* KT = (const bf16_t*)(p.ws + OFF_KT); const bf16_t* VT = (const bf16_t*)(p.ws + OFF_VT);
    bf16_t* KV = (bf16_t*)(p.ws + OFF_KV); float* NCH = (float*)(p.ws + OFF_NCH); float* WMAX = (float*)(p.ws + OFF_WMAX); float* BLAST = (float*)(p.ws + OFF_BLAST);
    for (int item = 256 + bid; item < 512; item += G) {
        const int cgi = item >> 2, h = item & 3, r0 = cgi * 64;
        const int idx0 = cgi * 4 + h, idx1 = (128 + cgi) * 4 + h;
        __syncthreads();
        if (wave == 0) {
            const float* gp = GATES + (size_t)(r0 + lane) * 16;
            const float li0 = gp[h], li1 = gp[4 + h], lf0 = gp[8 + h], lf1 = gp[12 + h];
            const float bf = prefix_sum64(lf0, lane), bb = suffix_sum64(lf1, lane);
            const float totf = __shfl(bf, 63), totb = __shfl(bb, 0);
            const float wf = totf - bf + li0, wb = totb - bb + li1;
            const float wmf = wave_max(wf), wmb = wave_max(wb);
            ew[lane] = __expf(wf - wmf); ew[64 + lane] = __expf(wb - wmb);
            if (lane == 0) { WMAX[idx0] = wmf; BLAST[idx0] = totf; WMAX[idx1] = wmb; BLAST[idx1] = totb; }
        }
        __syncthreads();
        if (tid < 256) {
            const int dir = tid >> 7, kd = tid & 127; const bf16_t* kp = KT + (size_t)(h * 128 + kd) * NTOK + r0; float a = 0.f;
#pragma unroll
            for (int i = 0; i < 8; ++i) { const u32x4 w = *(const u32x4*)(kp + 8 * i); const LAS float* e = ew + dir * 64 + 8 * i;
                a += bf_lo(w.x) * e[0] + bf_hi(w.x) * e[1] + bf_lo(w.y) * e[2] + bf_hi(w.y) * e[3] + bf_lo(w.z) * e[4] + bf_hi(w.z) * e[5] + bf_lo(w.w) * e[6] + bf_hi(w.w) * e[7]; }
            NCH[(size_t)(dir ? idx1 : idx0) * 128 + kd] = a;
        }
        bf16x8 vf[2][2];
#pragma unroll
        for (int mb = 0; mb < 2; ++mb)
#pragma unroll
            for (int ks = 0; ks < 2; ++ks) vf[mb][ks] = *(const bf16x8*)(VT + (size_t)(h * 256 + 32 * wave + 16 * mb + fr) * NTOK + r0 + 32 * ks + 8 * fq);
        float ewl[2][2][8];
#pragma unroll
        for (int dir = 0; dir < 2; ++dir)
#pragma unroll
            for (int ks = 0; ks < 2; ++ks)
#pragma unroll
                for (int e = 0; e < 8; ++e) ewl[dir][ks][e] = ew[dir * 64 + 32 * ks + 8 * fq + e];
        bf16x8 kfa[8][2];
#pragma unroll
        for (int nb = 0; nb < 8; ++nb)
#pragma unroll
            for (int ks = 0; ks < 2; ++ks) kfa[nb][ks] = *(const bf16x8*)(KT + (size_t)(h * 128 + 16 * nb + fr) * NTOK + r0 + 32 * ks + 8 * fq);
#pragma unroll
        for (int nb = 0; nb < 8; ++nb) {
#pragma unroll
            for (int dir = 0; dir < 2; ++dir) {
                f32x4 a0 = {0.f, 0.f, 0.f, 0.f}, a1 = {0.f, 0.f, 0.f, 0.f};
#pragma unroll
                for (int ks = 0; ks < 2; ++ks) { const bf16x8 kk = scale8(kfa[nb][ks], ewl[dir][ks]);
                    a0 = __builtin_amdgcn_mfma_f32_16x16x32_bf16(kk, vf[0][ks], a0, 0, 0, 0); a1 = __builtin_amdgcn_mfma_f32_16x16x32_bf16(kk, vf[1][ks], a1, 0, 0, 0); }
                bf16_t* o = KV + (size_t)(dir ? idx1 : idx0) * 32768 + (size_t)(32 * wave + fr) * 128 + 16 * nb + 4 * fq;
                u32x2 w0, w1; w0.x = cvt_pk_bf16(a0[0], a0[1]); w0.y = cvt_pk_bf16(a0[2], a0[3]); w1.x = cvt_pk_bf16(a1[0], a1[1]); w1.y = cvt_pk_bf16(a1[2], a1[3]);
                *(u32x2*)o = w0; *(u32x2*)(o + 16 * 128) = w1;
            }
        }
    }
    const bf16_t* U = (const bf16_t*)(p.ws + OFF_U); bf16_t* DP = (bf16_t*)(p.ws + OFF_DP);
    for (int wt = bid * 8 + wave; wt < 8192; wt += G * 8) {
        const int gi = wt & 3, r = (wt >> 2) * 4 + (lane >> 4), ch0 = gi * 128 + (lane & 15) * 8;
        int t, cols; if (r < NPROMPT) { t = r & 255; cols = 256; } else { t = (r - NPROMPT) & 63; cols = 64; }
        const int base = r - t;
        switch (gi) {
            case 0: pool_task<1>(U, DP, r, t, cols, base, ch0); break;
            case 1: pool_task<2>(U, DP, r, t, cols, base, ch0); break;
            case 2: pool_task<4>(U, DP, r, t, cols, base, ch0); break;
            default: pool_task<8>(U, DP, r, t, cols, base, ch0); break;
        }
    }
}

__device__ __forceinline__ void phase_prompt_final(const Params& p, LAS unsigned char* ldsb, int bid, int G) {
    int tid = threadIdx.x; asm volatile("" : "+v"(tid));
    const int wave = tid >> 6, lane = tid & 63, fr = lane & 15, fq = lane >> 4;
    LAS float* EW = (LAS float*)ldsb;
    LAS float* SC = EW + 256;
    LAS float* Ct = (LAS float*)(ldsb + 2048);
    const float* GATES = (const float*)(p.ws + OFF_GATES); const bf16_t* KT = (const bf16_t*)(p.ws + OFF_KT); const bf16_t* VT = (const bf16_t*)(p.ws + OFF_VT);
    for (int item = bid; item < 256; item += G) {
        const int sb = item >> 1, half = item & 1, b = sb >> 3, dir = (sb >> 2) & 1, h = sb & 3, r0 = b * 256, gcol = dir * 4 + h;
        __syncthreads();
        float wloc = 0.f;
        if (wave < 4) { const float* gp = GATES + (size_t)(r0 + 64 * wave + lane) * 16; const float li = gp[gcol], lf = gp[8 + gcol];
            const float cum = dir ? suffix_sum64(lf, lane) : prefix_sum64(lf, lane), tot = dir ? __shfl(cum, 0) : __shfl(cum, 63);
            if (lane == 0) SC[wave] = tot;
            wloc = li - cum; }
        __syncthreads();
        if (wave < 4) { float off = 0.f, bt = 0.f;
#pragma unroll
            for (int w2 = 0; w2 < 4; ++w2) { const float t = SC[w2]; bt += t; if (dir ? (w2 > wave) : (w2 < wave)) off += t; }
            const float wv = wloc + (bt - off), wm = wave_max(wv);
            EW[64 * wave + lane] = wv;
            if (lane == 0) { SC[4 + wave] = wm; SC[12] = bt; } }
        __syncthreads();
        const float wmax = fmaxf(fmaxf(SC[4], SC[5]), fmaxf(SC[6], SC[7])), btot = SC[12];
        const float mfin = fmaxf(btot, wmax), g = __expf(wmax - mfin);
        __syncthreads();
        if (tid < 256) EW[tid] = __expf(EW[tid] - wmax);
        __syncthreads();
        f32x4 C[8];
#pragma unroll
        for (int nb = 0; nb < 8; ++nb) C[nb] = (f32x4){0.f, 0.f, 0.f, 0.f};
        const int vrow = 128 * half + 16 * wave + fr;
#pragma unroll 2
        for (int ks = 0; ks < 8; ++ks) {
            const bf16x8 vf = *(const bf16x8*)(VT + (size_t)(h * 256 + vrow) * NTOK + r0 + 32 * ks + 8 * fq);
            const f32x4 e0 = *(const LAS f32x4*)(EW + 32 * ks + 8 * fq), e1 = *(const LAS f32x4*)(EW + 32 * ks + 8 * fq + 4);
            const float e8[8] = {e0.x, e0.y, e0.z, e0.w, e1.x, e1.y, e1.z, e1.w};
#pragma unroll
            for (int nb = 0; nb < 8; ++nb) { const bf16x8 kk = scale8(*(const bf16x8*)(KT + (size_t)(h * 128 + 16 * nb + fr) * NTOK + r0 + 32 * ks + 8 * fq), e8);
                C[nb] = __builtin_amdgcn_mfma_f32_16x16x32_bf16(kk, vf, C[nb], 0, 0, 0); }
        }
#pragma unroll
        for (int nb = 0; nb < 8; ++nb) *(LAS f32x4*)(Ct + (16 * wave + fr) * 132 + 16 * nb + 4 * fq) = C[nb] * g;
        if (half == 0 && tid < 128) { const bf16_t* kp = KT + (size_t)(h * 128 + tid) * NTOK + r0; float a = 0.f;
#pragma unroll 8
            for (int i = 0; i < 32; ++i) { const u32x4 w = *(const u32x4*)(kp + 8 * i); const LAS float* e = EW + 8 * i;
                a += bf_lo(w.x) * e[0] + bf_hi(w.x) * e[1] + bf_lo(w.y) * e[2] + bf_hi(w.y) * e[3] + bf_lo(w.z) * e[4] + bf_hi(w.z) * e[5] + bf_lo(w.w) * e[6] + bf_hi(w.w) * e[7]; }
            p.out[OUT_N + sb * 128 + tid] = g * a; if (tid == 0) p.out[OUT_M + sb] = mfin; }
        __syncthreads();
        { float* oc = p.out + OUT_C + (size_t)sb * 32768 + half * 128;
#pragma unroll
          for (int k = 0; k < 8; ++k) { const int q = tid + 512 * k, kd = q >> 5, v4 = (q & 31) * 4;
              const f32x4 o = {Ct[(v4 + 0) * 132 + kd], Ct[(v4 + 1) * 132 + kd], Ct[(v4 + 2) * 132 + kd], Ct[(v4 + 3) * 132 + kd]};
              __builtin_nontemporal_store(o, (f32x4*)(oc + (size_t)kd * 256 + v4)); } }
    }
}
struct SeqInfo { int sb, dir, h, nc, cg0, sample; };
__device__ __forceinline__ SeqInfo seq_info(int sidx) {
    SeqInfo s; int b;
    if (sidx < 16) { s.sample = 1; b = sidx >> 3; s.dir = (sidx >> 2) & 1; s.h = sidx & 3; s.nc = 32; s.cg0 = 64 + 32 * b; }
    else { const int q = sidx - 16; s.sample = 0; b = q >> 3; s.dir = (q >> 2) & 1; s.h = q & 3; s.nc = 4; s.cg0 = 4 * b; }
    s.sb = (b * 2 + s.dir) * 4 + s.h; return s;
}
__device__ __forceinline__ void unpack4(const u32x2& w, float (&f)[4]) { f[0] = bf_lo(w.x); f[1] = bf_hi(w.x); f[2] = bf_lo(w.y); f[3] = bf_hi(w.y); }
__device__ __forceinline__ void unpack8f(const u32x4& w, float (&f)[8]) { f[0] = bf_lo(w.x); f[1] = bf_hi(w.x); f[2] = bf_lo(w.y); f[3] = bf_hi(w.y); f[4] = bf_lo(w.z); f[5] = bf_hi(w.z); f[6] = bf_lo(w.w); f[7] = bf_hi(w.w); }

__device__ __forceinline__ void phase_scan(const Params& p, LAS unsigned char* ldsb, int bid, int G) {
    const int tid = threadIdx.x;
    LAS float* SA = (LAS float*)ldsb;
    LAS float* Ct = (LAS float*)(ldsb + 1024);
    bf16_t* KV = (bf16_t*)(p.ws + OFF_KV); float* NCH = (float*)(p.ws + OFF_NCH); const float* WMAX = (const float*)(p.ws + OFF_WMAX); const float* BLAST = (const float*)(p.ws + OFF_BLAST); float* MS = (float*)(p.ws + OFF_MS);
    for (int bt = bid; bt < 256; bt += G) {
        {
            const SeqInfo s = seq_info(bt >> 4); const int part = bt & 15;
            const int e0 = (part * 512 + tid) * 4, v = e0 >> 7, kd0 = e0 & 127;
            __syncthreads();
            if (tid < 32) { const int c = s.dir ? 31 - tid : tid, idx = (s.dir * 128 + s.cg0 + c) * 4 + s.h; SA[128 + tid] = BLAST[idx]; SA[160 + tid] = WMAX[idx]; }
            float C[4];
            { const float* c0 = p.in[2] + ((size_t)s.sb * 128 + kd0) * 256 + v;
#pragma unroll
              for (int e = 0; e < 4; ++e) C[e] = c0[(size_t)e * 256]; }
            u32x2 kv[16];
#pragma unroll
            for (int i = 0; i < 16; ++i) { const int c = s.dir ? 31 - i : i, idx = (s.dir * 128 + s.cg0 + c) * 4 + s.h; kv[i] = *(const u32x2*)(KV + (size_t)idx * 32768 + e0); }
            __syncthreads();
            if (tid == 0) { float m = p.in[4][s.sb];
                for (int i = 0; i < 32; ++i) { const float bl = SA[128 + i], wm = SA[160 + i], mn = fmaxf(m + bl, wm); SA[i] = __expf(m + bl - mn); SA[32 + i] = __expf(wm - mn); SA[64 + i] = m; m = mn; }
                SA[96] = m; }
            __syncthreads();
#pragma unroll 1
            for (int hh = 0; hh < 2; ++hh) {
                if (hh == 1) {
#pragma unroll
                    for (int i = 0; i < 16; ++i) { const int c = s.dir ? 15 - i : 16 + i, idx = (s.dir * 128 + s.cg0 + c) * 4 + s.h; kv[i] = *(const u32x2*)(KV + (size_t)idx * 32768 + e0); }
                }
#pragma unroll
                for (int i = 0; i < 16; ++i) { const float a = SA[hh * 16 + i], g = SA[32 + hh * 16 + i]; float f[4]; unpack4(kv[i], f);
                    kv[i].x = cvt_pk_bf16(C[0], C[1]); kv[i].y = cvt_pk_bf16(C[2], C[3]);
#pragma unroll
                    for (int e = 0; e < 4; ++e) C[e] = a * C[e] + g * f[e]; }
#pragma unroll
                for (int i = 0; i < 16; ++i) { const int ii = hh * 16 + i, c = s.dir ? 31 - ii : ii, idx = (s.dir * 128 + s.cg0 + c) * 4 + s.h; *(u32x2*)(KV + (size_t)idx * 32768 + e0) = kv[i]; }
            }
            if (part == 0 && tid < 128) {
                float n = p.in[3][s.sb * 128 + tid];
#pragma unroll 1
                for (int hh = 0; hh < 2; ++hh) {
                    float nv[16];
#pragma unroll
                    for (int i = 0; i < 16; ++i) { const int ii = hh * 16 + i, c = s.dir ? 31 - ii : ii, idx = (s.dir * 128 + s.cg0 + c) * 4 + s.h; nv[i] = NCH[(size_t)idx * 128 + tid]; }
#pragma unroll
                    for (int i = 0; i < 16; ++i) { const float t = nv[i]; nv[i] = n; n = SA[hh * 16 + i] * n + SA[32 + hh * 16 + i] * t; }
#pragma unroll
                    for (int i = 0; i < 16; ++i) { const int ii = hh * 16 + i, c = s.dir ? 31 - ii : ii, idx = (s.dir * 128 + s.cg0 + c) * 4 + s.h; NCH[(size_t)idx * 128 + tid] = nv[i]; if (tid == 0) MS[idx] = SA[64 + ii]; }
                }
            }
        }
        if (false) {
            const SeqInfo s = seq_info(16 + (bt >> 1)); const int half = bt & 1;
            __syncthreads();
            if (tid < 4) { const int c = s.dir ? 3 - tid : tid, idx = (s.dir * 128 + s.cg0 + c) * 4 + s.h; SA[128 + tid] = BLAST[idx]; SA[160 + tid] = WMAX[idx]; }
            __syncthreads();
            if (tid == 0) { float m = 0.f;
                for (int i = 0; i < 4; ++i) { const float bl = SA[128 + i], wm = SA[160 + i], mn = fmaxf(m + bl, wm); SA[i] = __expf(m + bl - mn); SA[32 + i] = __expf(wm - mn); SA[64 + i] = m; m = mn; }
                SA[96] = m; }
            __syncthreads();
            u32x4 kva[4][4];
#pragma unroll
            for (int j = 0; j < 4; ++j)
#pragma unroll
                for (int i = 0; i < 4; ++i) { const int c = s.dir ? 3 - i : i, idx = (s.dir * 128 + s.cg0 + c) * 4 + s.h; kva[j][i] = *(const u32x4*)(KV + (size_t)idx * 32768 + (size_t)(half * 2048 + tid + 512 * j) * 8); }
#pragma unroll
            for (int j = 0; j < 4; ++j) {
                u32x4 (&kvj)[4] = kva[j];
                float C[8];
#pragma unroll
                for (int e = 0; e < 8; ++e) C[e] = 0.f;
#pragma unroll
                for (int i = 0; i < 4; ++i) { const float a = SA[i], g = SA[32 + i]; float f[8]; unpack8f(kvj[i], f);
                    kvj[i].x = cvt_pk_bf16(C[0], C[1]); kvj[i].y = cvt_pk_bf16(C[2], C[3]); kvj[i].z = cvt_pk_bf16(C[4], C[5]); kvj[i].w = cvt_pk_bf16(C[6], C[7]);
#pragma unroll
                    for (int e = 0; e < 8; ++e) C[e] = a * C[e] + g * f[e]; }
#pragma unroll
                for (int i = 0; i < 4; ++i) { const int c = s.dir ? 3 - i : i, idx = (s.dir * 128 + s.cg0 + c) * 4 + s.h; *(u32x4*)(KV + (size_t)idx * 32768 + (size_t)(half * 2048 + tid + 512 * j) * 8) = kvj[i]; }
                LAS float* cp = Ct + (32 * j + (tid >> 4)) * 132 + (tid & 15) * 8;
                *(LAS f32x4*)cp = (f32x4){C[0], C[1], C[2], C[3]}; *(LAS f32x4*)(cp + 4) = (f32x4){C[4], C[5], C[6], C[7]};
            }
            __syncthreads();
            {
                float* oc = p.out + OUT_C + (size_t)s.sb * 32768 + half * 128;
#pragma unroll
                for (int k = 0; k < 8; ++k) { const int q = tid + 512 * k, kd = q >> 5, v4 = (q & 31) * 4;
                    const f32x4 o = {Ct[(v4 + 0) * 132 + kd], Ct[(v4 + 1) * 132 + kd], Ct[(v4 + 2) * 132 + kd], Ct[(v4 + 3) * 132 + kd]};
                    *(f32x4*)(oc + (size_t)kd * 256 + v4) = o; }
            }
            if (half == 0 && tid < 128) {
                float nv[4];
#pragma unroll
                for (int i = 0; i < 4; ++i) { const int c = s.dir ? 3 - i : i, idx = (s.dir * 128 + s.cg0 + c) * 4 + s.h; nv[i] = NCH[(size_t)idx * 128 + tid]; }
                float n = 0.f;
#pragma unroll
                for (int i = 0; i < 4; ++i) { const float t = nv[i]; nv[i] = n; n = SA[i] * n + SA[32 + i] * t; }
#pragma unroll
                for (int i = 0; i < 4; ++i) { const int c = s.dir ? 3 - i : i, idx = (s.dir * 128 + s.cg0 + c) * 4 + s.h; NCH[(size_t)idx * 128 + tid] = nv[i]; if (tid == 0) MS[idx] = SA[64 + i]; }
                p.out[OUT_N + s.sb * 128 + tid] = n; if (tid == 0) p.out[OUT_M + s.sb] = SA[96];
            }
        }
    }
}

__device__ __forceinline__ void phase_out(const Params& p, LAS unsigned char* ldsb, int bid, int G) {
    const int tid = threadIdx.x, wave = tid >> 6, lane = tid & 63, fr = lane & 15, fq = lane >> 4;
    LAS float* L = (LAS float*)ldsb;
    enum { COLF = 0, ROWF = 64, SCF = 128, EMF = 192, COLB = 256, ROWB = 320, SCB = 384, EMB = 448, RSF = 512, RSB = 576, QNF = 640, QNB = 704, CF = 768, CB = 832, SSQ = 896 };
    LAS bf16_t* Pp = (LAS bf16_t*)(ldsb + 4096);
    const float* GATES = (const float*)(p.ws + OFF_GATES); const float* MS = (const float*)(p.ws + OFF_MS); const float* NS = (const float*)(p.ws + OFF_NCH);
    const bf16_t* Q = (const bf16_t*)(p.ws + OFF_Q); const bf16_t* Kn = (const bf16_t*)(p.ws + OFF_KN); const bf16_t* VT = (const bf16_t*)(p.ws + OFF_VT);
    const bf16_t* CS = (const bf16_t*)(p.ws + OFF_KV); const bf16_t* SO = (const bf16_t*)(p.ws + OFF_SO); bf16_t* HM = (bf16_t*)(p.ws + OFF_HM);
    const float* ghead = p.in[15];
    for (int item = 256 + bid; item < 512; item += G) {
        const int cgi = item >> 2, h = item & 3, r0 = cgi * 64, idxf = cgi * 4 + h, idxb = (128 + cgi) * 4 + h;
        __syncthreads();
        if (wave == 0) {
            const float* gp = GATES + (size_t)(r0 + lane) * 16;
            const float li0 = gp[h], li1 = gp[4 + h], lf0 = gp[8 + h], lf1 = gp[12 + h], msf = MS[idxf], msb = MS[idxb];
            const float bf = prefix_sum64(lf0, lane), colf = li0 - bf, mxf = fmaxf(msf, prefix_max64(colf, lane));
            L[COLF + lane] = colf; L[ROWF + lane] = -mxf; L[SCF + lane] = __expf(msf - mxf); L[EMF + lane] = __expf(-(bf + mxf));
            const float bb = suffix_sum64(lf1, lane), colb = li1 - bb, mxb = fmaxf(msb, suffix_max64(colb, lane));
            L[COLB + lane] = colb; L[ROWB + lane] = -mxb; L[SCB + lane] = __expf(msb - mxb); L[EMB + lane] = __expf(-(bb + mxb));
            L[RSF + lane] = 0.f; L[RSB + lane] = 0.f; L[SSQ + lane] = 0.f;
        }
        {
            const int t = tid >> 3, part = tid & 7;
            const bf16_t* qp = Q + (size_t)(r0 + t) * 512 + h * 128 + 16 * part;
            const u32x4 w0 = *(const u32x4*)qp, w1 = *(const u32x4*)(qp + 8);
            float qv[16] = {bf_lo(w0.x), bf_hi(w0.x), bf_lo(w0.y), bf_hi(w0.y), bf_lo(w0.z), bf_hi(w0.z), bf_lo(w0.w), bf_hi(w0.w),
                            bf_lo(w1.x), bf_hi(w1.x), bf_lo(w1.y), bf_hi(w1.y), bf_lo(w1.z), bf_hi(w1.z), bf_lo(w1.w), bf_hi(w1.w)};
            const float* nf = NS + (size_t)idxf * 128 + 16 * part; const float* nb = NS + (size_t)idxb * 128 + 16 * part;
            float df = 0.f, db = 0.f;
#pragma unroll
            for (int e4 = 0; e4 < 4; ++e4) { const f32x4 a = *(const f32x4*)(nf + 4 * e4), b = *(const f32x4*)(nb + 4 * e4);
                df += qv[4 * e4] * a.x + qv[4 * e4 + 1] * a.y + qv[4 * e4 + 2] * a.z + qv[4 * e4 + 3] * a.w;
                db += qv[4 * e4] * b.x + qv[4 * e4 + 1] * b.y + qv[4 * e4 + 2] * b.z + qv[4 * e4 + 3] * b.w; }
            df += __shfl_xor(df, 1); df += __shfl_xor(df, 2); df += __shfl_xor(df, 4);
            db += __shfl_xor(db, 1); db += __shfl_xor(db, 2); db += __shfl_xor(db, 4);
            if (part == 0) { L[QNF + t] = df; L[QNB + t] = db; }
        }
        const int mb = wave >> 1, nb0 = 2 * (wave & 1);
        f32x4 S[2] = {{0.f, 0.f, 0.f, 0.f}, {0.f, 0.f, 0.f, 0.f}};
        {
            bf16x8 qf[4];
#pragma unroll
            for (int ks = 0; ks < 4; ++ks) qf[ks] = *(const bf16x8*)(Q + (size_t)(r0 + 16 * mb + fr) * 512 + h * 128 + 32 * ks + 8 * fq);
#pragma unroll
            for (int n2 = 0; n2 < 2; ++n2)
#pragma unroll
                for (int ks = 0; ks < 4; ++ks) { const bf16x8 kf = *(const bf16x8*)(Kn + (size_t)(r0 + 16 * (nb0 + n2) + fr) * 512 + h * 128 + 32 * ks + 8 * fq);
                    S[n2] = __builtin_amdgcn_mfma_f32_16x16x32_bf16(kf, qf[ks], S[n2], 0, 0, 0); }
        }
        __syncthreads();
        const int t = 16 * mb + fr;
        float pf[2][4], pb[2][4]; float sf = 0.f, sb = 0.f;
        {
            const float rowf = L[ROWF + t], rowb = L[ROWB + t];
#pragma unroll
            for (int n2 = 0; n2 < 2; ++n2)
#pragma unroll
                for (int jj = 0; jj < 4; ++jj) { const int s = 16 * (nb0 + n2) + 4 * fq + jj; const float sv = S[n2][jj];
                    pf[n2][jj] = (s <= t) ? sv * __expf(rowf + L[COLF + s]) : 0.f; pb[n2][jj] = (s >= t) ? sv * __expf(rowb + L[COLB + s]) : 0.f;
                    sf += pf[n2][jj]; sb += pb[n2][jj]; }
            sf += __shfl_xor(sf, 16); sf += __shfl_xor(sf, 32); sb += __shfl_xor(sb, 16); sb += __shfl_xor(sb, 32);
            if (fq == 0) { atomicAdd((float*)&L[RSF + t], sf); atomicAdd((float*)&L[RSB + t], sb); }
        }
        __syncthreads();
        {
            const float denf = L[RSF + t] + L[SCF + t] * L[QNF + t], denb = L[RSB + t] + L[SCB + t] * L[QNB + t];
            const float rf = 1.0f / fmaxf(fabsf(denf), L[EMF + t]), rb = 1.0f / fmaxf(fabsf(denb), L[EMB + t]);
#pragma unroll
            for (int n2 = 0; n2 < 2; ++n2) { u32x2 w; w.x = cvt_pk_bf16(rf * pf[n2][0] + rb * pb[n2][0], rf * pf[n2][1] + rb * pb[n2][1]);
                w.y = cvt_pk_bf16(rf * pf[n2][2] + rb * pb[n2][2], rf * pf[n2][3] + rb * pb[n2][3]);
                *(LAS u32x2*)(Pp + t * 72 + 16 * (nb0 + n2) + 4 * fq) = w; }
            if ((wave & 1) == 0 && fq == 0) { L[CF + t] = rf * L[SCF + t]; L[CB + t] = rb * L[SCB + t]; }
        }
        __syncthreads();
        f32x4 acc[4][2];
#pragma unroll
        for (int a = 0; a < 4; ++a) { acc[a][0] = (f32x4){0.f, 0.f, 0.f, 0.f}; acc[a][1] = (f32x4){0.f, 0.f, 0.f, 0.f}; }
        const int vb = 32 * wave;
#pragma unroll
        for (int ks = 0; ks < 2; ++ks) {
            bf16x8 vf[2];
#pragma unroll
            for (int nv = 0; nv < 2; ++nv) vf[nv] = *(const bf16x8*)(VT + (size_t)(h * 256 + vb + 16 * nv + fr) * NTOK + r0 + 32 * ks + 8 * fq);
#pragma unroll
            for (int m2 = 0; m2 < 4; ++m2) { const bf16x8 pr = *(const LAS bf16x8*)(Pp + (16 * m2 + fr) * 72 + 32 * ks + 8 * fq);
                acc[m2][0] = __builtin_amdgcn_mfma_f32_16x16x32_bf16(vf[0], pr, acc[m2][0], 0, 0, 0); acc[m2][1] = __builtin_amdgcn_mfma_f32_16x16x32_bf16(vf[1], pr, acc[m2][1], 0, 0, 0); }
        }
#pragma unroll
        for (int dir = 0; dir < 2; ++dir) {
            const bf16_t* cs = CS + (size_t)(dir ? idxb : idxf) * 32768;
            float scl[4];
#pragma unroll
            for (int m2 = 0; m2 < 4; ++m2) scl[m2] = L[(dir ? CB : CF) + 16 * m2 + fr];
#pragma unroll
            for (int ks = 0; ks < 4; ++ks) {
                bf16x8 cf[2];
#pragma unroll
                for (int nv = 0; nv < 2; ++nv) cf[nv] = __builtin_nontemporal_load((const bf16x8*)(cs + (size_t)(vb + 16 * nv + fr) * 128 + 32 * ks + 8 * fq));
#pragma unroll
                for (int m2 = 0; m2 < 4; ++m2) { const bf16x8 qs = scale8u(*(const bf16x8*)(Q + (size_t)(r0 + 16 * m2 + fr) * 512 + h * 128 + 32 * ks + 8 * fq), scl[m2]);
                    acc[m2][0] = __builtin_amdgcn_mfma_f32_16x16x32_bf16(cf[0], qs, acc[m2][0], 0, 0, 0); acc[m2][1] = __builtin_amdgcn_mfma_f32_16x16x32_bf16(cf[1], qs, acc[m2][1], 0, 0, 0); }
            }
        }
#pragma unroll
        for (int m2 = 0; m2 < 4; ++m2) { float s2 = 0.f;
#pragma unroll
            for (int nv = 0; nv < 2; ++nv)
#pragma unroll
                for (int jj = 0; jj < 4; ++jj) s2 += acc[m2][nv][jj] * acc[m2][nv][jj];
            s2 += __shfl_xor(s2, 16); s2 += __shfl_xor(s2, 32);
            if (fq == 0) atomicAdd((float*)&L[SSQ + 16 * m2 + fr], s2); }
        __syncthreads();
        u32x2 sov[4][2]; f32x4 gv[2];
#pragma unroll
        for (int nv = 0; nv < 2; ++nv) { gv[nv] = *(const f32x4*)(ghead + h * 256 + vb + 16 * nv + 4 * fq);
#pragma unroll
            for (int m2 = 0; m2 < 4; ++m2) sov[m2][nv] = *(const u32x2*)(SO + (size_t)(r0 + 16 * m2 + fr) * 1024 + h * 256 + vb + 16 * nv + 4 * fq); }
#pragma unroll
        for (int m2 = 0; m2 < 4; ++m2) { const int tt = 16 * m2 + fr, r = r0 + tt; const float rn = rsqrtf(L[SSQ + tt] * (1.0f / 256.0f) + EPSN);
#pragma unroll
            for (int nv = 0; nv < 2; ++nv) { const int col = h * 256 + vb + 16 * nv + 4 * fq; const f32x4 g = gv[nv]; const u32x2 so = sov[m2][nv];
                const f32x4 a = acc[m2][nv]; u32x2 w; w.x = cvt_pk_bf16(a[0] * rn * g.x * bf_lo(so.x), a[1] * rn * g.y * bf_hi(so.x)); w.y = cvt_pk_bf16(a[2] * rn * g.z * bf_lo(so.y), a[3] * rn * g.w * bf_hi(so.y));
                *(u32x2*)(HM + (size_t)r * 1024 + col) = w; } }
    }
}

__device__ __forceinline__ void phase_out_prompt(const Params& p, LAS unsigned char* ldsb, int bid, int G) {
    int tid = threadIdx.x; asm volatile("" : "+v"(tid));
    const int wave = tid >> 6, lane = tid & 63, fr = lane & 15, fq = lane >> 4;
    LAS float* L = (LAS float*)ldsb;
    enum { COLF = 0, COLB = 256, ROWF = 512, EMF = 576, ROWB = 640, EMB = 704, RSF = 768, RSB = 832, SSQ = 896, SCR = 960 };
    LAS bf16_t* Pp = (LAS bf16_t*)(ldsb + 4096);
    const float* GATES = (const float*)(p.ws + OFF_GATES);
    const bf16_t* Q = (const bf16_t*)(p.ws + OFF_Q); const bf16_t* Kn = (const bf16_t*)(p.ws + OFF_KN); const bf16_t* VT = (const bf16_t*)(p.ws + OFF_VT);
    const bf16_t* SO = (const bf16_t*)(p.ws + OFF_SO); bf16_t* HM = (bf16_t*)(p.ws + OFF_HM);
    const float* ghead = p.in[15];
    for (int item = bid; item < 256; item += G) {
        const int b = item >> 4, h = (item >> 2) & 3, j = item & 3, rs = b * 256, r0 = rs + 64 * j;
        __syncthreads();
        float cfl = 0.f, cbl = 0.f, pml = 0.f, sml = 0.f, bfl = 0.f, bbl = 0.f;
        if (wave < 4) { const float* gp = GATES + (size_t)(rs + 64 * wave + lane) * 16;
            const float li0 = gp[h], li1 = gp[4 + h], lf0 = gp[8 + h], lf1 = gp[12 + h];
            bfl = prefix_sum64(lf0, lane); bbl = suffix_sum64(lf1, lane); cfl = li0 - bfl; cbl = li1 - bbl;
            pml = prefix_max64(cfl, lane); sml = suffix_max64(cbl, lane);
            if (lane == 63) { L[SCR + wave] = bfl; L[SCR + 8 + wave] = pml; }
            if (lane == 0) { L[SCR + 4 + wave] = bbl; L[SCR + 12 + wave] = sml; } }
        if (tid < 64) { L[RSF + tid] = 0.f; L[RSB + tid] = 0.f; L[SSQ + tid] = 0.f; }
        const int mb = wave >> 1, nb0 = 8 * (wave & 1);
        f32x4 S[8];
        { bf16x8 qf[4];
#pragma unroll
          for (int ks = 0; ks < 4; ++ks) qf[ks] = *(const bf16x8*)(Q + (size_t)(r0 + 16 * mb + fr) * 512 + h * 128 + 32 * ks + 8 * fq);
#pragma unroll
          for (int n8 = 0; n8 < 8; ++n8) { S[n8] = (f32x4){0.f, 0.f, 0.f, 0.f};
#pragma unroll
              for (int ks = 0; ks < 4; ++ks) { const bf16x8 kf = *(const bf16x8*)(Kn + (size_t)(rs + 16 * (nb0 + n8) + fr) * 512 + h * 128 + 32 * ks + 8 * fq);
                  S[n8] = __builtin_amdgcn_mfma_f32_16x16x32_bf16(kf, qf[ks], S[n8], 0, 0, 0); } } }
        __syncthreads();
        if (wave < 4) { float offF = 0.f, offB = 0.f, carF = -3.0e38f, carB = -3.0e38f, run = 0.f;
            for (int w2 = 0; w2 < wave; ++w2) { carF = fmaxf(carF, L[SCR + 8 + w2] - run); run += L[SCR + w2]; }
            offF = run; run = 0.f;
            for (int w2 = 3; w2 > wave; --w2) { carB = fmaxf(carB, L[SCR + 12 + w2] - run); run += L[SCR + 4 + w2]; }
            offB = run;
            const float mxf = fmaxf(0.f, fmaxf(pml - offF, carF)), mxb = fmaxf(0.f, fmaxf(sml - offB, carB));
            L[COLF + 64 * wave + lane] = cfl - offF; L[COLB + 64 * wave + lane] = cbl - offB;
            if (wave == j) { L[ROWF + lane] = -mxf; L[EMF + lane] = __expf(-((bfl + offF) + mxf)); L[ROWB + lane] = -mxb; L[EMB + lane] = __expf(-((bbl + offB) + mxb)); } }
        __syncthreads();
        const int tl = 16 * mb + fr, tg = 64 * j + tl;
        float pf[8][4], pb[8][4];
        { const float rowf = L[ROWF + tl], rowb = L[ROWB + tl]; float sf = 0.f, sb = 0.f;
#pragma unroll
          for (int n8 = 0; n8 < 8; ++n8)
#pragma unroll
              for (int jj = 0; jj < 4; ++jj) { const int s = 16 * (nb0 + n8) + 4 * fq + jj; const float sv = S[n8][jj];
                  pf[n8][jj] = (s <= tg) ? sv * __expf(rowf + L[COLF + s]) : 0.f; pb[n8][jj] = (s >= tg) ? sv * __expf(rowb + L[COLB + s]) : 0.f;
                  sf += pf[n8][jj]; sb += pb[n8][jj]; }
          sf += __shfl_xor(sf, 16); sf += __shfl_xor(sf, 32); sb += __shfl_xor(sb, 16); sb += __shfl_xor(sb, 32);
          if (fq == 0) { atomicAdd((float*)&L[RSF + tl], sf); atomicAdd((float*)&L[RSB + tl], sb); } }
        __syncthreads();
        { const float rf = 1.0f / fmaxf(fabsf(L[RSF + tl]), L[EMF + tl]), rb = 1.0f / fmaxf(fabsf(L[RSB + tl]), L[EMB + tl]);
#pragma unroll
          for (int n8 = 0; n8 < 8; ++n8) { u32x2 w; w.x = cvt_pk_bf16(rf * pf[n8][0] + rb * pb[n8][0], rf * pf[n8][1] + rb * pb[n8][1]);
              w.y = cvt_pk_bf16(rf * pf[n8][2] + rb * pb[n8][2], rf * pf[n8][3] + rb * pb[n8][3]);
              *(LAS u32x2*)(Pp + tl * 264 + 16 * (nb0 + n8) + 4 * fq) = w; } }
        __syncthreads();
        f32x4 acc[4][2];
#pragma unroll
        for (int a = 0; a < 4; ++a) { acc[a][0] = (f32x4){0.f, 0.f, 0.f, 0.f}; acc[a][1] = (f32x4){0.f, 0.f, 0.f, 0.f}; }
        const int vb = 32 * wave;
#pragma unroll
        for (int ks = 0; ks < 8; ++ks) {
            bf16x8 vf[2];
#pragma unroll
            for (int nv = 0; nv < 2; ++nv) vf[nv] = *(const bf16x8*)(VT + (size_t)(h * 256 + vb + 16 * nv + fr) * NTOK + rs + 32 * ks + 8 * fq);
#pragma unroll
            for (int m2 = 0; m2 < 4; ++m2) { const bf16x8 pr = *(const LAS bf16x8*)(Pp + (16 * m2 + fr) * 264 + 32 * ks + 8 * fq);
                acc[m2][0] = __builtin_amdgcn_mfma_f32_16x16x32_bf16(vf[0], pr, acc[m2][0], 0, 0, 0); acc[m2][1] = __builtin_amdgcn_mfma_f32_16x16x32_bf16(vf[1], pr, acc[m2][1], 0, 0, 0); }
        }
#pragma unroll
        for (int m2 = 0; m2 < 4; ++m2) { float s2 = 0.f;
#pragma unroll
            for (int nv = 0; nv < 2; ++nv)
#pragma unroll
                for (int jj = 0; jj < 4; ++jj) s2 += acc[m2][nv][jj] * acc[m2][nv][jj];
            s2 += __shfl_xor(s2, 16); s2 += __shfl_xor(s2, 32);
            if (fq == 0) atomicAdd((float*)&L[SSQ + 16 * m2 + fr], s2); }
        u32x2 sov[4][2]; f32x4 gv[2];
#pragma unroll
        for (int nv = 0; nv < 2; ++nv) { gv[nv] = *(const f32x4*)(ghead + h * 256 + vb + 16 * nv + 4 * fq);
#pragma unroll
            for (int m2 = 0; m2 < 4; ++m2) sov[m2][nv] = *(const u32x2*)(SO + (size_t)(r0 + 16 * m2 + fr) * 1024 + h * 256 + vb + 16 * nv + 4 * fq); }
        __syncthreads();
#pragma unroll
        for (int m2 = 0; m2 < 4; ++m2) { const int tt = 16 * m2 + fr, r = r0 + tt; const float rn = rsqrtf(L[SSQ + tt] * (1.0f / 256.0f) + EPSN);
#pragma unroll
            for (int nv = 0; nv < 2; ++nv) { const int col = h * 256 + vb + 16 * nv + 4 * fq; const f32x4 g = gv[nv]; const u32x2 so = sov[m2][nv];
                const f32x4 a = acc[m2][nv]; u32x2 w; w.x = cvt_pk_bf16(a[0] * rn * g.x * bf_lo(so.x), a[1] * rn * g.y * bf_hi(so.x)); w.y = cvt_pk_bf16(a[2] * rn * g.z * bf_lo(so.y), a[3] * rn * g.w * bf_hi(so.y));
                *(u32x2*)(HM + (size_t)r * 1024 + col) = w; } }
    }
}

__device__ __forceinline__ void phase_norm2(const Params& p, int bid, int G) {
    const int wave = threadIdx.x >> 6, lane = threadIdx.x & 63;
    const float* MOD = (const float*)(p.ws + OFF_MOD); const bf16_t* Y = (const bf16_t*)(p.ws + OFF_T); const bf16_t* Y1 = (const bf16_t*)(p.ws + OFF_T + 16 * MiB); float* X1 = (float*)(p.ws + OFF_X1); bf16_t* H2 = (bf16_t*)(p.ws + OFF_H1);
    const float* gpost = p.in[10]; const float* gpre = p.in[11];
    for (int row = 2 * (bid * 8 + wave); row < NTOK; row += 2 * G * 8) {
        const float* x = row < NPROMPT ? p.in[0] + (size_t)row * 1024 : p.in[1] + (size_t)(row - NPROMPT) * 1024;
        const int ci = row < NPROMPT ? 0 : 1 + ((row - NPROMPT) >> 11);
        const float* md = MOD + ci * 6144;
        f32x4 yv[2][4], xi[2][4], gp[4], gt[4], gq[4], sh[4], sc[4];
#pragma unroll
        for (int j = 0; j < 4; ++j) { const int o = 256 * j + 4 * lane;
            gp[j] = *(const f32x4*)(gpost + o); gt[j] = *(const f32x4*)(md + 2048 + o); gq[j] = *(const f32x4*)(gpre + o); sh[j] = *(const f32x4*)(md + 3072 + o); sc[j] = *(const f32x4*)(md + 4096 + o);
#pragma unroll
            for (int q = 0; q < 2; ++q) { const size_t ro = (size_t)(row + q) * 1024 + o;
                const u32x2 a = __builtin_nontemporal_load((const u32x2*)(Y + ro)), b = __builtin_nontemporal_load((const u32x2*)(Y1 + ro)); yv[q][j] = (f32x4){bf_lo(a.x) + bf_lo(b.x), bf_hi(a.x) + bf_hi(b.x), bf_lo(a.y) + bf_lo(b.y), bf_hi(a.y) + bf_hi(b.y)};
                xi[q][j] = *(const f32x4*)(x + q * 1024 + o); } }
#pragma unroll
        for (int q = 0; q < 2; ++q) {
            float ss = 0.f;
#pragma unroll
            for (int j = 0; j < 4; ++j) ss += yv[q][j].x * yv[q][j].x + yv[q][j].y * yv[q][j].y + yv[q][j].z * yv[q][j].z + yv[q][j].w * yv[q][j].w;
            ss = wave_sum(ss); const float rstd = rsqrtf(ss * (1.0f / 1024.0f) + EPSN);
            f32x4 xv[4]; float s2 = 0.f;
#pragma unroll
            for (int j = 0; j < 4; ++j) { xv[j] = xi[q][j] + gt[j] * ((yv[q][j] * rstd) * gp[j]); s2 += xv[j].x * xv[j].x + xv[j].y * xv[j].y + xv[j].z * xv[j].z + xv[j].w * xv[j].w; }
            s2 = wave_sum(s2); const float rstd2 = rsqrtf(s2 * (1.0f / 1024.0f) + EPSN);
#pragma unroll
            for (int j = 0; j < 4; ++j) { const int o = 256 * j + 4 * lane;
                *(f32x4*)(X1 + (size_t)(row + q) * 1024 + o) = xv[j];
                const f32x4 hv = (xv[j] * rstd2) * gq[j] * (sc[j] + 1.0f) + sh[j];
                u32x2 w; w.x = cvt_pk_bf16(hv.x, hv.y); w.y = cvt_pk_bf16(hv.z, hv.w); *(u32x2*)(H2 + (size_t)(row + q) * 1024 + o) = w; }
        }
    }
}
__device__ __forceinline__ void phase_final(const Params& p, int bid, int G) {
    const int wave = threadIdx.x >> 6, lane = threadIdx.x & 63;
    const float* MOD = (const float*)(p.ws + OFF_MOD); const bf16_t* F = (const bf16_t*)(p.ws + OFF_T); const bf16_t* F1 = (const bf16_t*)(p.ws + OFF_T + 16 * MiB); const float* X1 = (const float*)(p.ws + OFF_X1);
    const float* gpost = p.in[12];
    const int stride = G * 8;
    for (int row0 = bid * 8 + wave; row0 < NTOK; row0 += 2 * stride) {
        const int rows[2] = {row0, (row0 + stride < NTOK) ? row0 + stride : row0};
        f32x4 yv[2][4], xi[2][4]; float ss[2] = {0.f, 0.f};
#pragma unroll
        for (int q = 0; q < 2; ++q)
#pragma unroll
            for (int j = 0; j < 4; ++j) { const size_t o = (size_t)rows[q] * 1024 + 256 * j + 4 * lane; { const u32x2 a = __builtin_nontemporal_load((const u32x2*)(F + o)), b = __builtin_nontemporal_load((const u32x2*)(F1 + o)); yv[q][j] = (f32x4){bf_lo(a.x) + bf_lo(b.x), bf_hi(a.x) + bf_hi(b.x), bf_lo(a.y) + bf_lo(b.y), bf_hi(a.y) + bf_hi(b.y)}; } xi[q][j] = __builtin_nontemporal_load((const f32x4*)(X1 + o));
                ss[q] += yv[q][j].x * yv[q][j].x + yv[q][j].y * yv[q][j].y + yv[q][j].z * yv[q][j].z + yv[q][j].w * yv[q][j].w; }
#pragma unroll
        for (int q = 0; q < 2; ++q) {
            if (q == 1 && rows[1] == rows[0]) break;
            const int row = rows[q]; const int ci = row < NPROMPT ? 0 : 1 + ((row - NPROMPT) >> 11); const float* md = MOD + ci * 6144;
            const float rstd = rsqrtf(wave_sum(ss[q]) * (1.0f / 1024.0f) + EPSN);
#pragma unroll
            for (int j = 0; j < 4; ++j) { const int o = 256 * j + 4 * lane; const f32x4 g = *(const f32x4*)(gpost + o), gt = *(const f32x4*)(md + 5120 + o);
                __builtin_nontemporal_store(xi[q][j] + gt * ((yv[q][j] * rstd) * g), (f32x4*)(p.out + (size_t)row * 1024 + o)); }
        }
    }
}
__device__ __forceinline__ void phase_conv(const Params& p, int bid, int G) {
    const bf16_t* UP = (const bf16_t*)(p.ws + OFF_UP); bf16_t* ACT = (bf16_t*)(p.ws + OFF_ACT);
    const float* cw = p.in[22]; const float* cb = p.in[23];
    const int T = G * 512;
    for (int q = bid * 512 + threadIdx.x; q < NTOK * (DFF / 8); q += T) {
        const int r = q / (DFF / 8), f0 = (q % (DFF / 8)) * 8;
        int t, cols; if (r < NPROMPT) { t = r & 255; cols = 256; } else { t = (r - NPROMPT) & 63; cols = 64; }
        float cv[2][8];
#pragma unroll
        for (int half = 0; half < 2; ++half) {
            const int col = half * DFF + f0;
            const f32x4 b0 = *(const f32x4*)(cb + col), b1 = *(const f32x4*)(cb + col + 4);
            float a[8] = {b0.x, b0.y, b0.z, b0.w, b1.x, b1.y, b1.z, b1.w};
#pragma unroll
            for (int k = 0; k < 3; ++k) { const int tt = t + k - 1; if (tt < 0 || tt >= cols) continue;
                const u32x4 w = *(const u32x4*)(UP + (size_t)(r + k - 1) * NUP + col);
                const f32x4 c0 = *(const f32x4*)(cw + k * NUP + col), c1 = *(const f32x4*)(cw + k * NUP + col + 4);
                a[0] += bf_lo(w.x) * c0.x; a[1] += bf_hi(w.x) * c0.y; a[2] += bf_lo(w.y) * c0.z; a[3] += bf_hi(w.y) * c0.w;
                a[4] += bf_lo(w.z) * c1.x; a[5] += bf_hi(w.z) * c1.y; a[6] += bf_lo(w.w) * c1.z; a[7] += bf_hi(w.w) * c1.w; }
#pragma unroll
            for (int e = 0; e < 8; ++e) cv[half][e] = a[e];
        }
        float o[8];
#pragma unroll
        for (int e = 0; e < 8; ++e) { const float x = cv[0][e]; const float gl = x * __builtin_amdgcn_rcpf(1.0f + __expf(-1.5957691216057308f * (x + 0.044715f * x * x * x))); o[e] = gl * cv[1][e]; }
        u32x4 w; w.x = cvt_pk_bf16(o[0], o[1]); w.y = cvt_pk_bf16(o[2], o[3]); w.z = cvt_pk_bf16(o[4], o[5]); w.w = cvt_pk_bf16(o[6], o[7]);
        *(u32x4*)(ACT + (size_t)r * DFF + f0) = w;
    }
}

#define XB_TMO      128
#define XB_XCNT(j)  (256  + 64 * (j))
#define XB_XSUB(j)  (1280 + 64 * (j))
#define XB_XGEN(j)  (2304 + 64 * (j))
#define XB_TOP      3328
#define XB_TOPGEN   3392
#define XCD_BAR_WORDS 3456
#define XB_SPIN_CAP (1u << 18)
__device__ __forceinline__ unsigned xb_ld(unsigned* p)              { return __hip_atomic_load(p, __ATOMIC_RELAXED, __HIP_MEMORY_SCOPE_AGENT); }
__device__ __forceinline__ unsigned xb_add(unsigned* p, unsigned v) { return __hip_atomic_fetch_add(p, v, __ATOMIC_RELAXED, __HIP_MEMORY_SCOPE_AGENT); }
__device__ __forceinline__ unsigned xb_xcc_id() { return (unsigned)__builtin_amdgcn_s_getreg((3 << 11) | 20) & 0xFu; }
#define XB_SPIN(cond, bar) do { unsigned _sp = 0; while (cond) { __builtin_amdgcn_s_sleep(1); \
    if ((++_sp & 255u) == 0u) { if (xb_ld(&(bar)[XB_TMO])) break; if (_sp > XB_SPIN_CAP) { atomicAdd(&(bar)[XB_TMO], 1u); break; } } } } while (0)
struct XcdBarrier { unsigned* bar; unsigned x; volatile LAS unsigned* st; };
__device__ __forceinline__ XcdBarrier xcd_barrier_post(unsigned* bar, volatile LAS unsigned* st) {
    XcdBarrier b; b.bar = bar; b.x = xb_xcc_id(); b.st = st;
    if (threadIdx.x == 0) (void)xb_add(&bar[XB_XCNT(b.x)], 1u);
    return b;
}
__device__ __forceinline__ void xcd_barrier_complete(unsigned* bar, unsigned x, unsigned& nloc, unsigned& nx) {
    const unsigned G = gridDim.x * gridDim.y * gridDim.z;
    unsigned sum, cnt, mine, sp = 0u;
    for (;;) {
        sum = 0u; cnt = 0u; mine = 0u;
#pragma unroll
        for (unsigned j = 0; j < 16; ++j) { const unsigned c = xb_ld(&bar[XB_XCNT(j)]); sum += c; cnt += (c > 0u) ? 1u : 0u; mine = (j == x) ? c : mine; }
        if (sum == G) break;
        __builtin_amdgcn_s_sleep(1);
        if ((++sp & 255u) == 0u) { if (xb_ld(&bar[XB_TMO])) break; if (sp > XB_SPIN_CAP) { atomicAdd(&bar[XB_TMO], 1u); break; } }
    }
    nloc = mine > 0u ? mine : 1u; nx = cnt > 0u ? cnt : 1u;
}
__device__ __forceinline__ void xcd_barrier(const XcdBarrier& b) {
    asm volatile("s_waitcnt vmcnt(0)" ::: "memory");
    __syncthreads();
    if (threadIdx.x == 0) {
        unsigned* bar = b.bar;
        __builtin_amdgcn_s_waitcnt(0);
        unsigned nloc = b.st[0], nx = b.st[1];
        if (nloc == 0u) { xcd_barrier_complete(bar, b.x, nloc, nx); b.st[0] = nloc; b.st[1] = nx; }
        const unsigned old = xb_add(&bar[XB_XSUB(b.x)], 1u);
        const unsigned gen = old / nloc;
        if (old + 1u == (gen + 1u) * nloc) {
            __builtin_amdgcn_fence(__ATOMIC_RELEASE, "agent");
            asm volatile("s_waitcnt vmcnt(0)" ::: "memory");
            const unsigned og = xb_add(&bar[XB_TOP], 1u);
            const unsigned tg = og / nx;
            if (og + 1u == (tg + 1u) * nx) xb_add(&bar[XB_TOPGEN], 1u);
            else XB_SPIN(xb_ld(&bar[XB_TOPGEN]) == tg, bar);
            __builtin_amdgcn_fence(__ATOMIC_ACQUIRE, "agent");
            xb_add(&bar[XB_XGEN(b.x)], 1u);
            asm volatile("s_waitcnt vmcnt(0)" ::: "memory");
        } else {
            XB_SPIN(xb_ld(&bar[XB_XGEN(b.x)]) == gen, bar);
            __builtin_amdgcn_fence(__ATOMIC_ACQUIRE, "agent");
            asm volatile("s_waitcnt vmcnt(0)" ::: "memory");
        }
    }
    __syncthreads();
}
constexpr size_t OFF_BAR = OFF_SMALL + 1280 * 1024;
constexpr int LDS_BYTES = 131072 + 256 + 8192;
#define GRID_SYNC() xcd_barrier(xb)

typedef const __attribute__((address_space(4))) Params* KParams;
#define PH_PARAMS() KParams q_ = (KParams)__builtin_amdgcn_kernarg_segment_ptr(); asm volatile("" : "+s"(q_)); Params p; _Pragma("unroll") for (int i_ = 0; i_ < 25; ++i_) p.in[i_] = q_->in[i_]; p.out = q_->out; p.ws = q_->ws; unsigned char* ws = p.ws; (void)ws
__global__ __launch_bounds__(512, 2) void mk_fwd(Params p_arg) {
    extern __shared__ __attribute__((aligned(16))) unsigned char shm[];
    LAS unsigned char* lds = (LAS unsigned char*)shm;
    cg::grid_group grid = cg::this_grid();
    const int bid = blockIdx.x, G = gridDim.x;
    pg8::StaticOrder S;
    volatile LAS unsigned* xst = (volatile LAS unsigned*)(lds + 131072);
    if (threadIdx.x == 0) { xst[0] = 0u; xst[1] = 0u; }
    __syncthreads();
    XcdBarrier xb; { PH_PARAMS(); xb = xcd_barrier_post((unsigned*)(ws + OFF_BAR), xst); }
    { PH_PARAMS();
    phase0(p, lds, bid, G);
    }
    __syncthreads();
    { PH_PARAMS(); if (p.ws == nullptr) grid.sync(); }
    { PH_PARAMS();
    phase_norm1(p, lds, bid, G);
    }
    GRID_SYNC();
    { PH_PARAMS();
    { pg8::Gemm g{(const bf16_t*)(ws + OFF_H1), (const bf16_t*)(ws + OFF_WT_IN), NTOK, NZ, 1024, 1024, (NZ) / 256}; S.init(NTOK, NZ, G, bid);
      EpiZ E{(bf16_t*)(ws + OFF_Q), (bf16_t*)(ws + OFF_KN), (bf16_t*)(ws + OFF_KT), (bf16_t*)(ws + OFF_VT), (bf16_t*)(ws + OFF_SO), (bf16_t*)(ws + OFF_U), (bf16_t*)(ws + OFF_SGA), (bf16_t*)(ws + OFF_SGB)};
      pg8::gemm_phase(lds, g, S, E); }
    }
    { PH_PARAMS();
      const int nfull = ((NTOK / 256) * (NZ / 256)) % G;
      if (nfull > 0 && bid >= nfull) tile_loop<2>(p, (LAS float*)lds, bid - nfull, G - nfull); else if (nfull == 0) tile_loop<2>(p, (LAS float*)lds, bid, G);
    }
    GRID_SYNC();
    { PH_PARAMS();
    phase_chunk(p, lds, bid, G);
    }
    if (G <= 128) { PH_PARAMS();
    phase_prompt_final(p, lds, bid, G);
    }
    GRID_SYNC();
    { PH_PARAMS();
    phase_scan(p, lds, bid, G);
    }
    GRID_SYNC();
    { PH_PARAMS();
    phase_out(p, lds, bid, G);
    }
    { PH_PARAMS();
    phase_out_prompt(p, lds, bid, G);
    }
    GRID_SYNC();
    if (G > 128 && bid >= 128) { PH_PARAMS();
    phase_prompt_final(p, lds, bid - 128, G - 128);
    }
    { PH_PARAMS();
    {{ pg8::Gemm g{(const bf16_t*)(ws + OFF_HM), (const bf16_t*)(ws + OFF_WT_BRA), NTOK, 1024, 1024, 1024, (1024) / 256}; S.init(NTOK, 1024, G, bid);
      EpiT1 E{(bf16_t*)(ws + OFF_T), (const bf16_t*)(ws + OFF_SGA)};
      pg8::gemm_phase(lds, g, S, E); }
    { pg8::Gemm g{(const bf16_t*)(ws + OFF_DP), (const bf16_t*)(ws + OFF_WT_EFF), NTOK, 1024, 512, 512, (1024) / 256}; S.init(NTOK, 1024, G, bid);
      EpiMix E{(const bf16_t*)(ws + OFF_T), (const bf16_t*)(ws + OFF_SGB), (bf16_t*)(ws + OFF_H1)};
      pg8::gemm_phase(lds, g, S, E); }}
    }
    GRID_SYNC();
    { PH_PARAMS();
    { pg8::Gemm g{(const bf16_t*)(ws + OFF_H1), (const bf16_t*)(ws + OFF_WT_OUT), NTOK, 1024, 512, 1024, 4}; S.init(NTOK, 2048, G, bid);
      EpiF32 E{(bf16_t*)(ws + OFF_T), (bf16_t*)(ws + OFF_T + 16 * MiB), 1024};
      pg8::gemm_phase(lds, g, S, E); }
    }
    GRID_SYNC();
    { PH_PARAMS();
    phase_norm2(p, bid, G);
    }
    GRID_SYNC();
    { PH_PARAMS();
    { pg8::Gemm g{(const bf16_t*)(ws + OFF_H1), (const bf16_t*)(ws + OFF_WT_UP), NTOK, NUP, 1024, 1024, (NUP) / 256}; S.init(NTOK, NUP, G, bid);
      EpiConv E{(bf16_t*)(ws + OFF_ACT), p.in[22], p.in[23], (LAS float*)(lds + 131072 + 256)};
      pg8::gemm_phase(lds, g, S, E); }
    }
    { PH_PARAMS();
      const int nfull = ((NTOK / 256) * (NUP / 256)) % G;
      if (nfull > 0 && bid >= nfull) tile_loop<1>(p, (LAS float*)lds, bid - nfull, G - nfull); else if (nfull == 0) tile_loop<1>(p, (LAS float*)lds, bid, G);
    }
    GRID_SYNC();
    { PH_PARAMS();
    { pg8::Gemm g{(const bf16_t*)(ws + OFF_ACT), (const bf16_t*)(ws + OFF_WT_DOWN), NTOK, 1024, DFF / 2, DFF, 4}; S.init(NTOK, 2048, G, bid);
      EpiF32 E{(bf16_t*)(ws + OFF_T), (bf16_t*)(ws + OFF_T + 16 * MiB), 1024};
      pg8::gemm_phase(lds, g, S, E); }
    }
    GRID_SYNC();
    { PH_PARAMS();
    phase_final(p, bid, G);
    }
}

extern "C" void kernel_launch(void* const* d_in, const int* in_sizes, int n_in, void* d_out, int out_size, void* d_ws, size_t ws_size, hipStream_t stream) {
    static int grid = 0;
    if (grid == 0) {
        if (n_in != 25 || ws_size < WS_NEED) { fprintf(stderr, "kernel_launch: unexpected inputs (n_in %d, ws %zu)\n", n_in, ws_size); grid = -1; return; }
        int dev = 0, cus = 0, per_cu = 0;
        if (hipGetDevice(&dev) != hipSuccess || hipDeviceGetAttribute(&cus, hipDeviceAttributeMultiprocessorCount, dev) != hipSuccess) { grid = -1; return; }
        if (hipFuncSetAttribute((const void*)mk_fwd, hipFuncAttributeMaxDynamicSharedMemorySize, LDS_BYTES) != hipSuccess) { fprintf(stderr, "kernel_launch: hipFuncSetAttribute failed\n"); grid = -1; return; }
        if (hipOccupancyMaxActiveBlocksPerMultiprocessor(&per_cu, (const void*)mk_fwd, 512, LDS_BYTES) != hipSuccess || per_cu < 1) { fprintf(stderr, "kernel_launch: occupancy query says %d blocks per CU\n", per_cu); (void)hipGetLastError(); per_cu = 1; }
        grid = cus;
    }
    if (grid < 0) return;
    if (hipMemsetAsync((char*)d_ws + OFF_BAR, 0, 16384 + 3 * 6144 * 4, stream) != hipSuccess) { fprintf(stderr, "kernel_launch: memset failed\n"); return; }
    Params p{};
    for (int i = 0; i < 25; ++i) p.in[i] = (const float*)d_in[i];
    p.out = (float*)d_out; p.ws = (unsigned char*)d_ws;
    void* args[] = {&p};
    hipError_t e = hipLaunchCooperativeKernel((const void*)mk_fwd, dim3(grid), dim3(512), args, LDS_BYTES, stream);
    if (e != hipSuccess) fprintf(stderr, "kernel_launch: cooperative launch failed: %s (grid %d)\n", hipGetErrorString(e), grid);
}
```
